# Optimizing an MI355X kernel written in HIP

```python
import jax, jax.numpy as jnp
from jax import lax
import numpy as np

D_MODEL = 1024
BATCH = 8
SEQ = 4096
DEPTH = 1

MIX_WIDTH = D_MODEL
RWKV_WIDTH = MIX_WIDTH // 2
RWKV_HEAD_DIM = 64
RWKV_HEADS = RWKV_WIDTH // RWKV_HEAD_DIM
RWKV_DECAY_LORA = 64
RWKV_AAA_LORA = 64
RWKV_GATE_LORA = 128
RWKV_GN_EPS = 64e-5
GLA_WIDTH = MIX_WIDTH - RWKV_WIDTH
GLA_HEADS = 4
GLA_DV = GLA_WIDTH // GLA_HEADS
GLA_DK = GLA_DV // 2
GLA_KEY_WIDTH = GLA_HEADS * GLA_DK
GLA_GATE_LORA = 16
GLA_GATE_TEMP = 16.0
GLA_CHUNK = 64
CONV_WIDTH = 3
PLE_DIM = 256
D_FF = -(-8 * D_MODEL // (3 * 256)) * 256
NORM_EPS = 1e-6

RWKV_SPLITS = (RWKV_WIDTH, 2 * RWKV_WIDTH, 3 * RWKV_WIDTH,
               3 * RWKV_WIDTH + 2 * RWKV_DECAY_LORA,
               3 * RWKV_WIDTH + 2 * RWKV_DECAY_LORA + RWKV_AAA_LORA)
RWKV_IN_WIDTH = RWKV_SPLITS[-1] + RWKV_GATE_LORA
GLA_SPLITS = (2 * GLA_KEY_WIDTH + GLA_WIDTH, 2 * GLA_KEY_WIDTH + 2 * GLA_WIDTH)
GLA_IN_WIDTH = GLA_SPLITS[-1] + 2 * GLA_GATE_LORA
IN_WIDTH = RWKV_IN_WIDTH + GLA_IN_WIDTH

kernel_name = 'hymba_rwkv7_gla_bidir_encoder_layer'


def rms_norm(x, w, eps=NORM_EPS):
    xf = x.astype(jnp.float32)
    y = xf * lax.rsqrt(jnp.mean(xf * xf, axis=-1, keepdims=True) + eps)
    return (y * w.astype(jnp.float32)).astype(x.dtype)


def centred_shift(z):
    zp = jnp.pad(z, ((0, 0), (1, 1), (0, 0)))
    return 0.5 * (zp[:, :-2] + zp[:, 2:])


def centred_dwconv(z, w):
    pad = (w.shape[0] - 1) // 2
    return lax.conv_general_dilated(z, w.astype(z.dtype), window_strides=(1,),
                                    padding=[(pad, pad)],
                                    dimension_numbers=('NWC', 'WIO', 'NWC'),
                                    feature_group_count=z.shape[-1])


def rwkv7_scan(r, decay, k, v, kk, b, reverse):
    B, T, H, N = r.shape
    xs = tuple(jnp.moveaxis(t, 1, 0) for t in (r, decay, k, v, kk, b))

    def step(S, inp):
        r_t, w_t, k_t, v_t, kk_t, b_t = inp
        sa = jnp.einsum('bhij,bhj->bhi', S, -kk_t)
        S = (S * w_t[:, :, None, :] + sa[..., None] * b_t[:, :, None, :]
             + v_t[..., None] * k_t[:, :, None, :])
        return S, jnp.einsum('bhij,bhj->bhi', S, r_t)

    S0 = jnp.zeros((B, H, N, N), r.dtype)
    _, y = lax.scan(step, S0, xs, reverse=reverse)
    return jnp.moveaxis(y, 0, 1)


def rwkv7_mixer(z, w0, w_up, a0, a_up, g_up, k_k, k_a, r_k, ln_w, ln_b, out_dtype):
    B, T, _ = z.shape
    z = z.astype(jnp.float32)
    r, k, v, w_lo, a_lo, g_lo = jnp.split(z, RWKV_SPLITS, axis=-1)
    w_lo = w_lo.reshape(B, T, 2, RWKV_DECAY_LORA)
    w_log = -jax.nn.softplus(-(w0 + jnp.einsum('btdr,drc->btdc', jnp.tanh(w_lo), w_up))) - 0.5
    decay = jnp.exp(-jnp.exp(w_log))
    a = jax.nn.sigmoid(a0 + a_lo @ a_up)
    g = jax.nn.sigmoid(g_lo) @ g_up

    def heads(t):
        return t.reshape(B, T, RWKV_HEADS, RWKV_HEAD_DIM)

    kk = heads(k * k_k)
    kk = kk * lax.rsqrt(jnp.maximum(jnp.sum(kk * kk, axis=-1, keepdims=True), 1e-24))
    k = k * (1.0 + (a - 1.0) * k_a)
    r_h, k_h, v_h, a_h = heads(r), heads(k), heads(v), heads(a)
    b_h = kk * a_h
    y = (rwkv7_scan(r_h, heads(decay[:, :, 0]), k_h, v_h, kk, b_h, False)
         + rwkv7_scan(r_h, heads(decay[:, :, 1]), k_h, v_h, kk, b_h, True))
    mu = jnp.mean(y, axis=-1, keepdims=True)
    var = jnp.mean(jnp.square(y - mu), axis=-1, keepdims=True)
    y = heads(((y - mu) * lax.rsqrt(var + RWKV_GN_EPS)).reshape(B, T, RWKV_WIDTH) * ln_w + ln_b)
    bonus = jnp.sum(r_h * k_h * r_k, axis=-1, keepdims=True) * v_h
    y = (y + bonus).reshape(B, T, RWKV_WIDTH)
    return (y * g).astype(out_dtype)


def gla_chunked(q, k, v, log_a):
    B, H, T, DK = q.shape
    DV = v.shape[-1]
    nc = T // GLA_CHUNK

    def to_chunks(t):
        return t.reshape(B, H, nc, GLA_CHUNK, t.shape[-1]).transpose(2, 0, 1, 3, 4)

    qc, kc, vc = to_chunks(q), to_chunks(k), to_chunks(v)
    bc = jnp.cumsum(to_chunks(log_a), axis=-2)
    mask = jnp.tril(jnp.ones((GLA_CHUNK, GLA_CHUNK), dtype=bool))[:, :, None]

    def step(S, inp):
        q_c, k_c, v_c, b_c = inp
        o_inter = jnp.einsum('bhcd,bhde->bhce', q_c * jnp.exp(b_c), S)
        diff = b_c[:, :, :, None, :] - b_c[:, :, None, :, :]
        dmat = jnp.exp(jnp.where(mask, diff, -jnp.inf))
        scores = jnp.einsum('bhid,bhjd,bhijd->bhij', q_c, k_c, dmat)
        o_intra = jnp.einsum('bhij,bhje->bhie', scores, v_c)
        b_last = b_c[:, :, -1:, :]
        S = (S * jnp.exp(b_last[:, :, 0, :])[..., None]
             + jnp.einsum('bhcd,bhce->bhde', k_c * jnp.exp(b_last - b_c), v_c))
        return S, o_inter + o_intra

    S0 = jnp.zeros((B, H, DK, DV), q.dtype)
    _, o = lax.scan(step, S0, (qc, kc, vc, bc))
    return o.transpose(1, 2, 0, 3, 4).reshape(B, H, T, DV)


def gla_mixer(z, conv_w, a_up, a_b, norm_w, out_dtype):
    B, T, _ = z.shape
    z = z.astype(jnp.float32)
    qkv, g, a_lo = jnp.split(z, GLA_SPLITS, axis=-1)
    qkv = jax.nn.silu(centred_dwconv(qkv, conv_w))
    q, k, v = jnp.split(qkv, (GLA_KEY_WIDTH, 2 * GLA_KEY_WIDTH), axis=-1)
    a_lo = a_lo.reshape(B, T, 2, GLA_GATE_LORA)
    log_a = jax.nn.log_sigmoid(jnp.einsum('btdr,drc->btdc', a_lo, a_up) + a_b) / GLA_GATE_TEMP

    def heads(t, d):
        return t.reshape(B, T, GLA_HEADS, d).transpose(0, 2, 1, 3)

    def flip(t):
        return jnp.flip(t, axis=2)

    q_h = heads(q, GLA_DK) * GLA_DK ** -0.5
    k_h = heads(k, GLA_DK)
    v_h = heads(v, GLA_DV)
    o_f = gla_chunked(q_h, k_h, v_h, heads(log_a[:, :, 0], GLA_DK))
    o_b = flip(gla_chunked(flip(q_h), flip(k_h), flip(v_h), flip(heads(log_a[:, :, 1], GLA_DK))))
    o = (o_f + o_b).transpose(0, 2, 1, 3)
    o = rms_norm(o, norm_w) * jax.nn.silu(g.reshape(B, T, GLA_HEADS, GLA_DV))
    return o.reshape(B, T, GLA_WIDTH).astype(out_dtype)


def setup_inputs(seed: int = 0) -> dict:
    key = jax.random.key(seed)
    ks = jax.random.split(key, 32)
    L = DEPTH
    f32 = jnp.float32

    def nrm(k, shape, scale):
        return jax.random.normal(k, shape, f32) * scale

    def gain(k, shape):
        return 1.0 + 0.05 * jax.random.normal(k, shape, f32)

    return {
        'x': jax.random.normal(ks[0], (BATCH, SEQ, D_MODEL), f32),
        'p': jax.random.normal(ks[1], (DEPTH, BATCH, SEQ, PLE_DIM), f32),
        'norm_mix_pre': gain(ks[2], (L, D_MODEL)),
        'norm_mix_post': gain(ks[3], (L, D_MODEL)),
        'norm_ffn_pre': gain(ks[4], (L, D_MODEL)),
        'norm_ffn_post': gain(ks[5], (L, D_MODEL)),
        'norm_ple': gain(ks[6], (L, D_MODEL)),
        'w_in': nrm(ks[7], (L, D_MODEL, IN_WIDTH), D_MODEL ** -0.5),
        'rwkv_mu': jax.random.uniform(ks[8], (L, RWKV_IN_WIDTH), f32),
        'rwkv_w0': jax.random.uniform(ks[9], (L, 2, RWKV_WIDTH), f32, -6.0, -1.0),
        'rwkv_w_up': nrm(ks[10], (L, 2, RWKV_DECAY_LORA, RWKV_WIDTH), RWKV_DECAY_LORA ** -0.5),
        'rwkv_a0': nrm(ks[11], (L, RWKV_WIDTH), 0.3),
        'rwkv_a_up': nrm(ks[12], (L, RWKV_AAA_LORA, RWKV_WIDTH), 0.5 * RWKV_AAA_LORA ** -0.5),
        'rwkv_g_up': nrm(ks[13], (L, RWKV_GATE_LORA, RWKV_WIDTH), RWKV_GATE_LORA ** -0.5),
        'rwkv_k_k': 0.85 + 0.05 * jax.random.normal(ks[14], (L, RWKV_WIDTH), f32),
        'rwkv_k_a': gain(ks[15], (L, RWKV_WIDTH)),
        'rwkv_r_k': nrm(ks[16], (L, RWKV_HEADS, RWKV_HEAD_DIM), 0.1),
        'rwkv_ln_w': gain(ks[17], (L, RWKV_WIDTH)),
        'rwkv_ln_b': nrm(ks[18], (L, RWKV_WIDTH), 0.02),
        'gla_conv': nrm(ks[19], (L, CONV_WIDTH, 1, 2 * GLA_KEY_WIDTH + GLA_WIDTH), CONV_WIDTH ** -0.5),
        'gla_a_up': nrm(ks[20], (L, 2, GLA_GATE_LORA, GLA_KEY_WIDTH), GLA_GATE_LORA ** -0.5),
        'gla_a_b': 2.0 + 0.5 * jax.random.normal(ks[21], (L, 2, GLA_KEY_WIDTH), f32),
        'gla_norm': gain(ks[22], (L, GLA_DV)),
        'w_out': nrm(ks[23], (L, MIX_WIDTH, D_MODEL), MIX_WIDTH ** -0.5),
        'ffn_gate': nrm(ks[24], (L, D_MODEL, D_FF), D_MODEL ** -0.5),
        'ffn_up': nrm(ks[25], (L, D_MODEL, D_FF), D_MODEL ** -0.5),
        'ffn_down': nrm(ks[26], (L, D_FF, D_MODEL), D_FF ** -0.5),
        'ple_proj': nrm(ks[27], (L, PLE_DIM, D_MODEL), PLE_DIM ** -0.5),
        'ple_gate': nrm(ks[28], (L, D_MODEL, D_MODEL), D_MODEL ** -0.5),
        'ple_gate_b': nrm(ks[29], (L, D_MODEL), 0.02),
    }


def reference(x, p, norm_mix_pre, norm_mix_post, norm_ffn_pre, norm_ffn_post, norm_ple,
              w_in, rwkv_mu, rwkv_w0, rwkv_w_up, rwkv_a0, rwkv_a_up, rwkv_g_up,
              rwkv_k_k, rwkv_k_a, rwkv_r_k, rwkv_ln_w, rwkv_ln_b,
              gla_conv, gla_a_up, gla_a_b, gla_norm, w_out,
              ffn_gate, ffn_up, ffn_down, ple_proj, ple_gate, ple_gate_b):
    h = x
    for i in range(DEPTH):
        xn = rms_norm(h, norm_mix_pre[i])
        z = xn @ w_in[i]
        z_rwkv, z_gla = z[..., :RWKV_IN_WIDTH], z[..., RWKV_IN_WIDTH:]
        z_rwkv = z_rwkv + rwkv_mu[i] * (centred_shift(z_rwkv) - z_rwkv)
        y_rwkv = rwkv7_mixer(z_rwkv, rwkv_w0[i], rwkv_w_up[i], rwkv_a0[i], rwkv_a_up[i],
                             rwkv_g_up[i], rwkv_k_k[i], rwkv_k_a[i], rwkv_r_k[i],
                             rwkv_ln_w[i], rwkv_ln_b[i], h.dtype)
        y_gla = gla_mixer(z_gla, gla_conv[i], gla_a_up[i], gla_a_b[i], gla_norm[i], h.dtype)
        y = jnp.concatenate([y_rwkv, y_gla], axis=-1) @ w_out[i]
        h = h + rms_norm(y, norm_mix_post[i])
        hn = rms_norm(h, norm_ffn_pre[i])
        f = (jax.nn.silu(hn @ ffn_gate[i]) * (hn @ ffn_up[i])) @ ffn_down[i]
        h = h + rms_norm(f, norm_ffn_post[i])
        e = p[i] @ ple_proj[i]
        gate = jax.nn.sigmoid(h @ ple_gate[i] + ple_gate_b[i])
        h = h + rms_norm(gate * e, norm_ple[i])
    return h
```

```cpp
#include <hip/hip_runtime.h>
#include <hip/hip_cooperative_groups.h>
#include <cstdio>
namespace cg = cooperative_groups;
namespace pg8 {
#define PG8_LAS __attribute__((address_space(3)))
typedef unsigned short bf16_t;
typedef short bf16x8 __attribute__((ext_vector_type(8)));
typedef float f32x4 __attribute__((ext_vector_type(4)));
typedef float f32x2 __attribute__((ext_vector_type(2)));
typedef unsigned u32x4 __attribute__((ext_vector_type(4)));
typedef unsigned u32x2 __attribute__((ext_vector_type(2)));
constexpr int BM = 256, BK = 64, HALF = 128, HTB = HALF * BK * 2, STAGE_BYTES = 8 * HTB, NXCD = 8, WGM = 8;
__host__ __device__ __forceinline__ int lds_byte(int r, int c) { const int st = (r >> 4) * 2 + (c >> 5), rr = r & 15, cc = c & 31, ob = rr * 64 + cc * 2; return st * 1024 + (ob ^ (((ob >> 9) & 1) << 5)); }
__host__ __device__ __forceinline__ void stage_rc(int b, int& R, int& C) { const int st = b / 1024, sb = b % 1024, swz = sb ^ (((sb >> 9) & 1) << 5); R = (st >> 1) * 16 + swz / 64; C = (st & 1) * 32 + (swz % 64) / 2; }
__host__ __device__ __forceinline__ int perm32(int rho) { const int n = rho >> 4, i = rho & 15; return 8 * (i >> 2) + 4 * n + (i & 3); }
struct Unit { int pm, pn; };
struct Gemm { const bf16_t* A; const bf16_t* Bt; int M, N, K; };
struct StaticOrder {
    int nM, nN, nwg, G, c;
    __host__ __device__ void init(int M, int N, int G_, int c_) { nM = M / BM; nN = N / BM; nwg = nM * nN; G = G_; c = c_; }
    __host__ __device__ bool next(int i, Unit& u) const {
        const long L = (long)i * G + c; if (L >= nwg) return false;
        int wgid = (int)L; { const int q = nwg / NXCD, r = nwg % NXCD, xcd = wgid % NXCD, off = wgid / NXCD; wgid = (xcd < r ? xcd * (q + 1) : r * (q + 1) + (xcd - r) * q) + off; }
        const int nig = WGM * nN, gid = wgid / nig, fm = gid * WGM, gsz = (nM - fm) < WGM ? (nM - fm) : WGM;
        u.pm = fm + ((wgid % nig) % gsz); u.pn = (wgid % nig) / gsz; return true;
    }
    __device__ __forceinline__ void a_ready(const Unit&) const {}
    __device__ __forceinline__ void done(const Unit&) const {}
};
__device__ __forceinline__ unsigned cvt_pk_bf16(float lo, float hi) { unsigned r; asm volatile("v_cvt_pk_bf16_f32 %0, %1, %2" : "=v"(r) : "v"(lo), "v"(hi)); return r; }
template <class Epi, class Sched>
__device__ __forceinline__ void gemm_phase(PG8_LAS unsigned char* lds, const Gemm g, const Sched& S, const Epi& E) {
    int tid_ = threadIdx.x; asm volatile("" : "+v"(tid_));
    const int tid = tid_, wid = __builtin_amdgcn_readfirstlane(tid >> 6), lane = tid & 63, wr = wid >> 2, wc = wid & 3, fr = lane & 15, fq = lane >> 4;
    const int K = g.K, nt = K / BK;
    unsigned voffA[2], voffB[2];
#pragma unroll
    for (int i = 0; i < 2; ++i) { int R, C; stage_rc(tid * 16 + i * 8192, R, C); const int Rb = Epi::PERM ? ((R & ~31) + perm32(R & 31)) : R;
        voffA[i] = (unsigned)(R * K + C) * 2u; voffB[i] = (unsigned)(Rb * K + C) * 2u; }
    const size_t kstep = (size_t)(BK * 2);
    const size_t hstep = (size_t)HALF * K * 2;
    const size_t tstep = 2 * hstep;
    const unsigned ldsw = (unsigned)wid * 1024u;
    const int aoff = lds_byte(wr * 64 + fr, fq * 8), boff = lds_byte(wc * 32 + fr, fq * 8);
#define PG8_SA(b, h) (((b) * 2 + (h)) * HTB)
#define PG8_SB(b, h) ((4 + (b) * 2 + (h)) * HTB)
#define PG8_STAGE(bufoff, gbase, voff) do { _Pragma("unroll") for (int _i = 0; _i < 2; ++_i) \
        __builtin_amdgcn_global_load_lds((const unsigned*)((const char*)(gbase) + (voff)[_i]), (PG8_LAS unsigned*)(lds + (bufoff) + ldsw + _i * 8192), 16, 0, 0); } while (0)
#define PG8_LDA(dst, b, h) do { _Pragma("unroll") for (int m = 0; m < 4; ++m) _Pragma("unroll") for (int k = 0; k < 2; ++k) dst[m][k] = *(const PG8_LAS bf16x8*)(lds + PG8_SA(b, h) + aoff + m * 2048 + k * 1024); } while (0)
#define PG8_LDB(dst, b, h) do { _Pragma("unroll") for (int n = 0; n < 2; ++n) _Pragma("unroll") for (int k = 0; k < 2; ++k) dst[n][k] = *(const PG8_LAS bf16x8*)(lds + PG8_SB(b, h) + boff + n * 2048 + k * 1024); } while (0)
#define PG8_MMA(ai, bj, At, Bt) do { __builtin_amdgcn_s_setprio(1); _Pragma("unroll") for (int m = 0; m < 4; ++m) _Pragma("unroll") for (int n = 0; n < 2; ++n) _Pragma("unroll") for (int k = 0; k < 2; ++k) \
        acc[ai][bj][m][n] = __builtin_amdgcn_mfma_f32_16x16x32_bf16(Bt[n][k], At[m][k], acc[ai][bj][m][n], 0, 0, 0); __builtin_amdgcn_s_setprio(0); } while (0)
#define PG8_WAIT_V(n) asm volatile("s_waitcnt vmcnt(" #n ")" ::: "memory")
#define PG8_WAIT_L(n) asm volatile("s_waitcnt lgkmcnt(" #n ")" ::: "memory")
#define PG8_BAR __builtin_amdgcn_s_barrier()
#define PG8_SCHED __builtin_amdgcn_sched_barrier(0)
    Unit cur, nxt; int ui = 0;
    if (!S.next(0, cur)) return;
    f32x4 acc[2][2][4][2];
#pragma unroll
    for (int a = 0; a < 2; ++a)
#pragma unroll
        for (int b = 0; b < 2; ++b)
#pragma unroll
            for (int m = 0; m < 4; ++m)
#pragma unroll
                for (int n = 0; n < 2; ++n) acc[a][b][m][n] = (f32x4){0.f, 0.f, 0.f, 0.f};
    bf16x8 At[4][2], B0[2][2], B1[2][2];
    const char* cA = (const char*)g.A + (size_t)cur.pm * tstep; const char* cB = (const char*)g.Bt + (size_t)cur.pn * tstep;
    S.a_ready(cur);
    PG8_STAGE(PG8_SB(0, 0), cB, voffB); PG8_STAGE(PG8_SA(0, 0), cA, voffA); PG8_STAGE(PG8_SB(0, 1), cB + hstep, voffB); PG8_STAGE(PG8_SA(0, 1), cA + hstep, voffA);
    if (wr == 1) PG8_BAR;
    PG8_WAIT_V(4); PG8_BAR;
    PG8_STAGE(PG8_SB(1, 0), cB + kstep, voffB); PG8_STAGE(PG8_SA(1, 0), cA + kstep, voffA); PG8_STAGE(PG8_SB(1, 1), cB + hstep + kstep, voffB);
    PG8_WAIT_V(6); PG8_BAR;
    for (;;) {
        const bool has_next = S.next(ui + 1, nxt);
        const char* nA = has_next ? (const char*)g.A + (size_t)nxt.pm * tstep : cA; const char* nB = has_next ? (const char*)g.Bt + (size_t)nxt.pn * tstep : cB;
        for (int t = 0; t < nt; t += 2) {
            const bool last = (t == nt - 2);
            const char* a1 = cA + (size_t)(t + 1) * kstep;
            const char* a2 = last ? nA : cA + (size_t)(t + 2) * kstep; const char* b2 = last ? nB : cB + (size_t)(t + 2) * kstep;
            const char* a3 = a2 + kstep; const char* b3 = b2 + kstep;
            if (last && has_next) S.a_ready(nxt);
            PG8_LDB(B0, 0, 0); PG8_SCHED; PG8_LDA(At, 0, 0); PG8_STAGE(PG8_SA(1, 1), a1 + hstep, voffA);
            PG8_WAIT_L(8); PG8_BAR; PG8_WAIT_L(0); PG8_MMA(0, 0, At, B0); PG8_BAR; PG8_SCHED;
            PG8_LDB(B1, 0, 1); PG8_STAGE(PG8_SB(0, 0), b2, voffB);
            PG8_BAR; PG8_WAIT_L(0); PG8_MMA(0, 1, At, B1); PG8_BAR;
            PG8_LDA(At, 0, 1); PG8_STAGE(PG8_SA(0, 0), a2, voffA);
            PG8_BAR; PG8_WAIT_L(0); PG8_MMA(1, 0, At, B0); PG8_BAR; PG8_SCHED;
            PG8_STAGE(PG8_SB(0, 1), b2 + hstep, voffB);
            PG8_WAIT_V(6); PG8_BAR; PG8_MMA(1, 1, At, B1); PG8_BAR;
            PG8_LDB(B0, 1, 0); PG8_SCHED; PG8_LDA(At, 1, 0); PG8_STAGE(PG8_SA(0, 1), a2 + hstep, voffA);
            PG8_WAIT_L(8); PG8_BAR; PG8_WAIT_L(0); PG8_MMA(0, 0, At, B0); PG8_BAR; PG8_SCHED;
            PG8_LDB(B1, 1, 1); PG8_STAGE(PG8_SB(1, 0), b3, voffB);
            PG8_BAR; PG8_WAIT_L(0); PG8_MMA(0, 1, At, B1); PG8_BAR;
            PG8_LDA(At, 1, 1); PG8_STAGE(PG8_SA(1, 0), a3, voffA);
            PG8_BAR; PG8_WAIT_L(0); PG8_MMA(1, 0, At, B0); PG8_BAR; PG8_SCHED;
            PG8_STAGE(PG8_SB(1, 1), b3 + hstep, voffB);
            PG8_WAIT_V(6); PG8_BAR; PG8_MMA(1, 1, At, B1); PG8_BAR;
        }
        if constexpr (!Epi::AFTER_DRAIN) { E(acc, cur, wr, wc, fr, fq); S.done(cur); }
        if (!has_next) break;
#pragma unroll
        for (int a = 0; a < 2; ++a)
#pragma unroll
            for (int b = 0; b < 2; ++b)
#pragma unroll
                for (int m = 0; m < 4; ++m)
#pragma unroll
                    for (int n = 0; n < 2; ++n) acc[a][b][m][n] = (f32x4){0.f, 0.f, 0.f, 0.f};
        cur = nxt; cA = nA; cB = nB; ++ui;
    }
    PG8_WAIT_V(0);
    if (wr == 0) PG8_BAR;
    PG8_BAR;
    if constexpr (Epi::AFTER_DRAIN) { E.fused(acc, cur, wr, wc, fr, fq, lds, wid, lane); S.done(cur); }
#undef PG8_SA
#undef PG8_SB
#undef PG8_STAGE
#undef PG8_LDA
#undef PG8_LDB
#undef PG8_MMA
#undef PG8_WAIT_V
#undef PG8_WAIT_L
#undef PG8_BAR
#undef PG8_SCHED
}
}
using namespace pg8;
#define LAS PG8_LAS
constexpr int M_TOK = 32768, T_SEQ = 4096, DM = 1024, ZLD = 3584, NRW = 1856, DFF = 2816, KLORA = 384;
constexpr float NEPS = 1e-6f;
constexpr size_t MiB = 1u << 20;
constexpr size_t WS_W1T = 0, WS_W2T = 7 * MiB, WS_W3T = 9 * MiB, WS_W4T = 11 * MiB, WS_W5T = 22 * MiB, WS_W6T = 27 * MiB + MiB / 2, WS_W7T = 28 * MiB;
constexpr size_t WS_PB = 30 * MiB, WS_RINV = 46 * MiB, WS_SS = 47 * MiB, WS_BAR = 47 * MiB + MiB / 2;
constexpr size_t WS_XN = 48 * MiB, WS_GNL = 48 * MiB, WS_GG = 80 * MiB, WS_HN = 48 * MiB;
constexpr size_t WS_Z = 112 * MiB, WS_KK = 112 * MiB, WS_NB = 144 * MiB, WS_DF = 176 * MiB, WS_DB = 208 * MiB, WS_G = 240 * MiB, WS_YMIX = 272 * MiB;
constexpr size_t WS_H1 = 112 * MiB, WS_ACT = 240 * MiB, WS_E = 416 * MiB;
constexpr size_t WS_RKV = 336 * MiB, WS_GQKV = 432 * MiB, WS_Y = 336 * MiB;
constexpr size_t WS_END = 496 * MiB;

struct Params { const float* in[30]; float* out; unsigned char* ws; };

__device__ __forceinline__ unsigned pk2(float lo, float hi) { unsigned r; asm("v_cvt_pk_bf16_f32 %0, %1, %2" : "=v"(r) : "v"(lo), "v"(hi)); return r; }
__device__ __forceinline__ float bflo(unsigned w) { return __uint_as_float(w << 16); }
__device__ __forceinline__ float bfhi(unsigned w) { return __uint_as_float(w & 0xffff0000u); }
__device__ __forceinline__ void unpack8(const u32x4 w, float (&f)[8]) { f[0] = bflo(w.x); f[1] = bfhi(w.x); f[2] = bflo(w.y); f[3] = bfhi(w.y); f[4] = bflo(w.z); f[5] = bfhi(w.z); f[6] = bflo(w.w); f[7] = bfhi(w.w); }
__device__ __forceinline__ u32x4 pack8(const float (&f)[8]) { u32x4 o; o.x = pk2(f[0], f[1]); o.y = pk2(f[2], f[3]); o.z = pk2(f[4], f[5]); o.w = pk2(f[6], f[7]); return o; }
__device__ __forceinline__ void unpack4(const u32x2 w, float (&f)[4]) { f[0] = bflo(w.x); f[1] = bfhi(w.x); f[2] = bflo(w.y); f[3] = bfhi(w.y); }
__device__ __forceinline__ float wave_sum(float v) {
#pragma unroll
    for (int o = 1; o < 64; o <<= 1) v += __shfl_xor(v, o);
    return v;
}
__device__ __forceinline__ float sigmoidf_(float x) { return __builtin_amdgcn_rcpf(1.0f + __expf(-x)); }
__device__ __forceinline__ float siluf_(float x) { return x * __builtin_amdgcn_rcpf(1.0f + __expf(-x)); }
__device__ __forceinline__ float tanhf_(float x) { return 1.0f - 2.0f * __builtin_amdgcn_rcpf(__expf(2.0f * x) + 1.0f); }

struct EpiBf16Plain {
    static constexpr bool PERM = true, AFTER_DRAIN = false;
    bf16_t* O; int ldc;
    __device__ __forceinline__ void operator()(const f32x4 (&acc)[2][2][4][2], const Unit& u, int wr, int wc, int fr, int fq) const {
        const int row0 = u.pm * BM + wr * 64 + fr, col0 = u.pn * BM + wc * 32 + 8 * fq;
#pragma unroll
        for (int ai = 0; ai < 2; ++ai)
#pragma unroll
            for (int m = 0; m < 4; ++m) { bf16_t* rowp = O + (size_t)(row0 + ai * HALF + m * 16) * ldc + col0;
#pragma unroll
                for (int bj = 0; bj < 2; ++bj) { const f32x4 v0 = acc[ai][bj][m][0], v1 = acc[ai][bj][m][1]; u32x4 w; w.x = pk2(v0[0], v0[1]); w.y = pk2(v0[2], v0[3]); w.z = pk2(v1[0], v1[1]); w.w = pk2(v1[2], v1[3]);
                    *(u32x4*)(rowp + bj * HALF) = w; } }
    }
};
struct EpiBf16SS {
    static constexpr bool PERM = true, AFTER_DRAIN = false;
    bf16_t* O; int ldc; float* ss;
    __device__ __forceinline__ void operator()(const f32x4 (&acc)[2][2][4][2], const Unit& u, int wr, int wc, int fr, int fq) const {
        const int row0 = u.pm * BM + wr * 64 + fr, col0 = u.pn * BM + wc * 32 + 8 * fq;
#pragma unroll
        for (int ai = 0; ai < 2; ++ai)
#pragma unroll
            for (int m = 0; m < 4; ++m) { const int row = row0 + ai * HALF + m * 16; bf16_t* rowp = O + (size_t)row * ldc + col0; float s = 0.f;
#pragma unroll
                for (int bj = 0; bj < 2; ++bj) { const f32x4 v0 = acc[ai][bj][m][0], v1 = acc[ai][bj][m][1]; u32x4 w; w.x = pk2(v0[0], v0[1]); w.y = pk2(v0[2], v0[3]); w.z = pk2(v1[0], v1[1]); w.w = pk2(v1[2], v1[3]);
                    *(u32x4*)(rowp + bj * HALF) = w; s += ((v0[0] * v0[0] + v0[1] * v0[1]) + (v0[2] * v0[2] + v0[3] * v0[3])) + ((v1[0] * v1[0] + v1[1] * v1[1]) + (v1[2] * v1[2] + v1[3] * v1[3])); }
                { auto r16 = __builtin_amdgcn_permlane16_swap(__float_as_uint(s), __float_as_uint(s), false, false); s = __uint_as_float(r16[0]) + __uint_as_float(r16[1]);
                  auto r32 = __builtin_amdgcn_permlane32_swap(__float_as_uint(s), __float_as_uint(s), false, false); s = __uint_as_float(r32[0]) + __uint_as_float(r32[1]); }
                if (fq == 0) atomicAdd(ss + row, s); }
    }
};
struct EpiSwiGLU {
    static constexpr bool PERM = true, AFTER_DRAIN = false;
    bf16_t* O;
    __device__ __forceinline__ void operator()(const f32x4 (&acc)[2][2][4][2], const Unit& u, int wr, int wc, int fr, int fq) const {
        const int row0 = u.pm * BM + wr * 64 + fr, col0 = u.pn * 128 + wc * 32 + 8 * fq;
#pragma unroll
        for (int ai = 0; ai < 2; ++ai)
#pragma unroll
            for (int m = 0; m < 4; ++m) { bf16_t* rowp = O + (size_t)(row0 + ai * HALF + m * 16) * DFF + col0; float o[8];
#pragma unroll
                for (int n = 0; n < 2; ++n) { const f32x4 g = acc[ai][0][m][n], up = acc[ai][1][m][n];
#pragma unroll
                    for (int j = 0; j < 4; ++j) o[4 * n + j] = siluf_(g[j]) * up[j]; }
                u32x4 w; w.x = pk2(o[0], o[1]); w.y = pk2(o[2], o[3]); w.z = pk2(o[4], o[5]); w.w = pk2(o[6], o[7]); *(u32x4*)rowp = w; }
    }
};
struct EpiLoraW {
    static constexpr bool PERM = true, AFTER_DRAIN = false;
    const float* w0; bf16_t *DFp, *DBp;
    __device__ __forceinline__ void operator()(const f32x4 (&acc)[2][2][4][2], const Unit& u, int wr, int wc, int fr, int fq) const {
        const int row0 = u.pm * BM + wr * 64 + fr, cb = 128 * u.pn + wc * 32 + 8 * fq;
#pragma unroll
        for (int bj = 0; bj < 2; ++bj) {
            const f32x4 w0a = *(const f32x4*)(w0 + 512 * bj + cb), w0b = *(const f32x4*)(w0 + 512 * bj + cb + 4); bf16_t* D = bj ? DBp : DFp;
#pragma unroll
            for (int ai = 0; ai < 2; ++ai)
#pragma unroll
                for (int m = 0; m < 4; ++m) { const f32x4 a0 = acc[ai][bj][m][0], a1 = acc[ai][bj][m][1]; float d[8];
#pragma unroll
                    for (int j = 0; j < 4; ++j) { d[j] = 0.60653066f * sigmoidf_(w0a[j] + a0[j]); d[4 + j] = 0.60653066f * sigmoidf_(w0b[j] + a1[j]); }
                    *(u32x4*)(D + (size_t)(row0 + ai * HALF + m * 16) * 512 + cb) = pack8(d); asm volatile("" ::: "memory"); }
        }
    }
};
struct EpiLoraAG {
    static constexpr bool PERM = true, AFTER_DRAIN = false;
    const float *a0, *k_k, *k_a; const float* rinv; bf16_t *RKV, *KK, *NB, *G;
    __device__ __forceinline__ void operator()(const f32x4 (&acc)[2][2][4][2], const Unit& u, int wr, int wc, int fr, int fq) const {
        const int row0 = u.pm * BM + wr * 64 + fr, cb = 128 * u.pn + wc * 32 + 8 * fq;
#pragma unroll
        for (int ai = 0; ai < 2; ++ai)
#pragma unroll
            for (int m = 0; m < 4; ++m) { const f32x4 g0 = acc[ai][1][m][0], g1 = acc[ai][1][m][1]; u32x4 w; w.x = pk2(g0[0], g0[1]); w.y = pk2(g0[2], g0[3]); w.z = pk2(g1[0], g1[1]); w.w = pk2(g1[2], g1[3]);
                *(u32x4*)(G + (size_t)(row0 + ai * HALF + m * 16) * 512 + cb) = w; }
        asm volatile("" ::: "memory");
#pragma unroll
        for (int ai = 0; ai < 2; ++ai)
#pragma unroll
            for (int m = 0; m < 4; ++m) { const int row = row0 + ai * HALF + m * 16; const size_t off = (size_t)row * 512 + cb; bf16_t* kp = RKV + (size_t)row * 1536 + 512 + cb;
                float ks[8], av[8], t[8]; unpack8(*(const u32x4*)kp, ks);
                { const f32x4 c0 = *(const f32x4*)(a0 + cb), c1 = *(const f32x4*)(a0 + cb + 4); const f32x4 x0 = acc[ai][0][m][0], x1 = acc[ai][0][m][1];
#pragma unroll
                  for (int j = 0; j < 4; ++j) { av[j] = sigmoidf_(c0[j] + x0[j]); av[4 + j] = sigmoidf_(c1[j] + x1[j]); } }
                { const f32x4 c0 = *(const f32x4*)(k_a + cb), c1 = *(const f32x4*)(k_a + cb + 4);
#pragma unroll
                  for (int j = 0; j < 4; ++j) { t[j] = ks[j] * (1.0f + (av[j] - 1.0f) * c0[j]); t[4 + j] = ks[4 + j] * (1.0f + (av[4 + j] - 1.0f) * c1[j]); } }
                *(u32x4*)kp = pack8(t);
                { const f32x4 c0 = *(const f32x4*)(k_k + cb), c1 = *(const f32x4*)(k_k + cb + 4); const float ri = rinv[row * 8 + (cb >> 6)];
#pragma unroll
                  for (int j = 0; j < 4; ++j) { t[j] = ks[j] * c0[j] * ri; t[4 + j] = ks[4 + j] * c1[j] * ri; } }
                *(u32x4*)(KK + off) = pack8(t);
#pragma unroll
                for (int e = 0; e < 8; ++e) t[e] = -t[e] * av[e];
                *(u32x4*)(NB + off) = pack8(t);
                asm volatile("" ::: "memory"); }
    }
};
struct EpiPleGate {
    static constexpr bool PERM = true, AFTER_DRAIN = false;
    bf16_t* C; const float* bias; const bf16_t* E; float* ss;
    __device__ __forceinline__ void operator()(const f32x4 (&acc)[2][2][4][2], const Unit& u, int wr, int wc, int fr, int fq) const {
        const int row0 = u.pm * BM + wr * 64 + fr, col0 = u.pn * BM + wc * 32 + 8 * fq;
        f32x4 bv[2][2];
#pragma unroll
        for (int bj = 0; bj < 2; ++bj)
#pragma unroll
            for (int n = 0; n < 2; ++n) bv[bj][n] = *(const f32x4*)(bias + col0 + bj * HALF + 4 * n);
#pragma unroll
        for (int ai = 0; ai < 2; ++ai)
#pragma unroll
            for (int m = 0; m < 4; ++m) { const int row = row0 + ai * HALF + m * 16; const size_t off = (size_t)row * DM + col0; float s = 0.f;
#pragma unroll
                for (int bj = 0; bj < 2; ++bj) { float e[8], o[8]; unpack8(*(const u32x4*)(E + off + bj * HALF), e);
#pragma unroll
                    for (int n = 0; n < 2; ++n) { const f32x4 v = acc[ai][bj][m][n] + bv[bj][n];
#pragma unroll
                        for (int j = 0; j < 4; ++j) { o[4 * n + j] = sigmoidf_(v[j]) * e[4 * n + j]; s += o[4 * n + j] * o[4 * n + j]; } }
                    *(u32x4*)(C + off + bj * HALF) = pack8(o); }
                { auto r16 = __builtin_amdgcn_permlane16_swap(__float_as_uint(s), __float_as_uint(s), false, false); s = __uint_as_float(r16[0]) + __uint_as_float(r16[1]);
                  auto r32 = __builtin_amdgcn_permlane32_swap(__float_as_uint(s), __float_as_uint(s), false, false); s = __uint_as_float(r32[0]) + __uint_as_float(r32[1]); }
                if (fq == 0) atomicAdd(ss + row, s); }
    }
};
#define XB_TMO      128
#define XB_XCNT(j)  (256  + 64 * (j))
#define XB_XSUB(j)  (1280 + 64 * (j))
#define XB_XGEN(j)  (2304 + 64 * (j))
#define XB_TOP      3328
#define XB_TOPGEN   3392
#define XCD_BAR_WORDS 3456
#define XB_SPIN_CAP (1u << 18)

__device__ __forceinline__ unsigned xb_ld(unsigned* p)              { return __hip_atomic_load(p, __ATOMIC_RELAXED, __HIP_MEMORY_SCOPE_AGENT); }
__device__ __forceinline__ unsigned xb_add(unsigned* p, unsigned v) { return __hip_atomic_fetch_add(p, v, __ATOMIC_RELAXED, __HIP_MEMORY_SCOPE_AGENT); }
__device__ __forceinline__ unsigned xb_xcc_id() { return (unsigned)__builtin_amdgcn_s_getreg((3 << 11) | 20) & 0xFu; }
#define XB_SPIN(cond, bar) do { unsigned _sp = 0; while (cond) { __builtin_amdgcn_s_sleep(1); \
    if ((++_sp & 255u) == 0u) { if (xb_ld(&(bar)[XB_TMO])) break; if (_sp > XB_SPIN_CAP) { atomicAdd(&(bar)[XB_TMO], 1u); break; } } } } while (0)

struct XcdBarrier {
    unsigned* bar; unsigned x;
    volatile LAS unsigned* st;
};

__device__ __forceinline__ XcdBarrier xcd_barrier_post(unsigned* bar, volatile LAS unsigned* st) {
    XcdBarrier b; b.bar = bar; b.x = xb_xcc_id(); b.st = st;
    if (threadIdx.x == 0) (void)xb_add(&bar[XB_XCNT(b.x)], 1u);
    return b;
}
__device__ __forceinline__ void xcd_barrier_complete(unsigned* bar, unsigned x, unsigned& nloc, unsigned& nx) {
    const unsigned G = gridDim.x * gridDim.y * gridDim.z;
    unsigned sum, cnt, mine, sp = 0u;
    for (;;) {
        sum = 0u; cnt = 0u; mine = 0u;
#pragma unroll
        for (unsigned j = 0; j < 16; ++j) { const unsigned c = xb_ld(&bar[XB_XCNT(j)]); sum += c; cnt += (c > 0u) ? 1u : 0u; mine = (j == x) ? c : mine; }
        if (sum == G) break;
        __builtin_amdgcn_s_sleep(1);
        if ((++sp & 255u) == 0u) { if (xb_ld(&bar[XB_TMO])) break; if (sp > XB_SPIN_CAP) { atomicAdd(&bar[XB_TMO], 1u); break; } }
    }
    nloc = mine > 0u ? mine : 1u; nx = cnt > 0u ? cnt : 1u;
}

__device__ __forceinline__ void xcd_barrier(const XcdBarrier& b) {
    asm volatile("s_waitcnt vmcnt(0)" ::: "memory");
    __syncthreads();
    if (threadIdx.x == 0) {
        unsigned* bar = b.bar;
        __builtin_amdgcn_s_waitcnt(0);
        unsigned nloc = b.st[0], nx = b.st[1];
        if (nloc == 0u) { xcd_barrier_complete(bar, b.x, nloc, nx); b.st[0] = nloc; b.st[1] = nx; }
        const unsigned old = xb_add(&bar[XB_XSUB(b.x)], 1u);
        const unsigned gen = old / nloc;
        if (old + 1u == (gen + 1u) * nloc) {
            __builtin_amdgcn_fence(__ATOMIC_RELEASE, "agent");
            asm volatile("s_waitcnt vmcnt(0)" ::: "memory");
            const unsigned og = xb_add(&bar[XB_TOP], 1u);
            const unsigned tg = og / nx;
            if (og + 1u == (tg + 1u) * nx) xb_add(&bar[XB_TOPGEN], 1u);
            else XB_SPIN(xb_ld(&bar[XB_TOPGEN]) == tg, bar);
            __builtin_amdgcn_fence(__ATOMIC_ACQUIRE, "agent");
            xb_add(&bar[XB_XGEN(b.x)], 1u);
            asm volatile("s_waitcnt vmcnt(0)" ::: "memory");
        } else {
            XB_SPIN(xb_ld(&bar[XB_XGEN(b.x)]) == gen, bar);
            __builtin_amdgcn_fence(__ATOMIC_ACQUIRE, "agent");
            asm volatile("s_waitcnt vmcnt(0)" ::: "memory");
        }
    }
    __syncthreads();
}

__device__ __forceinline__ float red8s(float x) {
    x += __int_as_float(__builtin_amdgcn_update_dpp(0, __float_as_int(x), 0xB1, 0xF, 0xF, true));
    x += __int_as_float(__builtin_amdgcn_update_dpp(0, __float_as_int(x), 0x4E, 0xF, 0xF, true));
    x += __int_as_float(__builtin_amdgcn_update_dpp(0, __float_as_int(x), 0x141, 0xF, 0xF, true));
    return x;
}
__device__ __forceinline__ float red16s(float x) { x = red8s(x); x += __int_as_float(__builtin_amdgcn_update_dpp(0, __float_as_int(x), 0x140, 0xF, 0xF, true)); return x; }
__device__ __forceinline__ void transpose_item(const float* W, int N, int col0, bf16_t* WT, int K, int drow0, int k0, LAS float* scr, int lane) {
#pragma unroll 8
    for (int i = 0; i < 32; ++i) { const int kk = 2 * i + (lane >> 5); scr[kk * 33 + (lane & 31)] = col0 >= 0 ? __builtin_nontemporal_load(W + (size_t)(k0 + kk) * N + col0 + (lane & 31)) : 0.f; }
    asm volatile("s_waitcnt lgkmcnt(0)" ::: "memory");
    const int c = lane & 7;
#pragma unroll
    for (int j = 0; j < 4; ++j) { const int n = (lane >> 3) + 8 * j; const LAS float* s = scr + (8 * c) * 33 + n;
        u32x4 o; o.x = pk2(s[0 * 33], s[1 * 33]); o.y = pk2(s[2 * 33], s[3 * 33]); o.z = pk2(s[4 * 33], s[5 * 33]); o.w = pk2(s[6 * 33], s[7 * 33]);
        *(u32x4*)(WT + (size_t)(drow0 + n) * K + k0 + 8 * c) = o; }
    asm volatile("s_waitcnt lgkmcnt(0)" ::: "memory");
}
__device__ __forceinline__ void phase0(const Params& p, LAS unsigned char* lds, int wid, int lane) {
    unsigned char* ws = p.ws;
    LAS float* scr = (LAS float*)(lds + wid * 8448);
    const int gw = blockIdx.x * 8 + wid, NGW = gridDim.x * 8;
    constexpr int I1 = 16 * 112, I3 = 16 * 32, I4 = 16 * 176, I5 = 44 * 32, I6 = 4 * 32, I7 = 16 * 32, NIT = I1 + I3 + I4 + I5 + I6 + I7;
    for (int it = gw; it < NIT; it += NGW) {
        int r = it;
        if (r < I1) { const int kb = r / 112, nb = r % 112; transpose_item(p.in[7], 3424, nb * 32 < 3424 ? nb * 32 : -1, (bf16_t*)(ws + WS_W1T), 1024, nb * 32, kb * 64, scr, lane); continue; } r -= I1;
        if (r < I3) { const int kb = r / 32, nb = r % 32; transpose_item(p.in[23], 1024, nb * 32, (bf16_t*)(ws + WS_W3T), 1024, nb * 32, kb * 64, scr, lane); continue; } r -= I3;
        if (r < I4) { const int kb = r / 176, nb = r % 176, n0 = nb * 32, u = n0 >> 8, bj = (n0 >> 7) & 1, cc = n0 & 127;
            transpose_item(bj ? p.in[25] : p.in[24], DFF, 128 * u + cc, (bf16_t*)(ws + WS_W4T), 1024, n0, kb * 64, scr, lane); continue; } r -= I4;
        if (r < I5) { const int kb = r / 32, nb = r % 32; transpose_item(p.in[26], 1024, nb * 32, (bf16_t*)(ws + WS_W5T), DFF, nb * 32, kb * 64, scr, lane); continue; } r -= I5;
        if (r < I6) { const int kb = r / 32, nb = r % 32; transpose_item(p.in[27], 1024, nb * 32, (bf16_t*)(ws + WS_W6T), 256, nb * 32, kb * 64, scr, lane); continue; } r -= I6;
        { const int kb = r / 32, nb = r % 32; transpose_item(p.in[28], 1024, nb * 32, (bf16_t*)(ws + WS_W7T), 1024, nb * 32, kb * 64, scr, lane); }
    }
    const int gt = blockIdx.x * 512 + threadIdx.x, GT = gridDim.x * 512;
    {
        bf16_t* W2 = (bf16_t*)(ws + WS_W2T); const float* wup = p.in[10]; const float* aup = p.in[12]; const float* gup = p.in[13];
        for (int idx = gt; idx < 2048 * KLORA; idx += GT) { const int n = idx / KLORA, kk = idx % KLORA, u = n >> 8, bj = (n >> 7) & 1, col = 128 * (u & 3) + (n & 127); float v = 0.f;
            if (u < 4) { if (bj == 0) { if (kk < 64) v = wup[(size_t)kk * 512 + col]; } else { if (kk >= 64 && kk < 128) v = wup[(size_t)(64 + kk - 64) * 512 + col]; } }
            else { if (bj == 0) { if (kk >= 128 && kk < 192) v = aup[(size_t)(kk - 128) * 512 + col]; } else { if (kk >= 192 && kk < 320) v = gup[(size_t)(kk - 192) * 512 + col]; } }
            W2[idx] = (bf16_t)(pk2(v, 0.f) & 0xffffu); }
    }
    {
        const f32x4* src = (const f32x4*)p.in[1]; u32x2* dst = (u32x2*)(ws + WS_PB);
        for (int i = gt; i < M_TOK * 256 / 4; i += GT) { const f32x4 v = __builtin_nontemporal_load(src + i); u32x2 w; w.x = pk2(v[0], v[1]); w.y = pk2(v[2], v[3]); __builtin_nontemporal_store(w, dst + i); }
        float* ss = (float*)(ws + WS_SS);
        for (int i = gt; i < 3 * M_TOK; i += GT) ss[i] = 0.f;
    }
    {
        const float* nw = p.in[2]; f32x4 wv[4];
#pragma unroll
        for (int j = 0; j < 4; ++j) wv[j] = *(const f32x4*)(nw + 4 * lane + 256 * j);
        bf16_t* XN = (bf16_t*)(ws + WS_XN);
        for (int t = gw; t < M_TOK; t += NGW) { const float* xr = p.in[0] + (size_t)t * DM; f32x4 v[4]; float s = 0.f;
#pragma unroll
            for (int j = 0; j < 4; ++j) { v[j] = __builtin_nontemporal_load((const f32x4*)(xr + 4 * lane + 256 * j)); s += (v[j][0] * v[j][0] + v[j][1] * v[j][1]) + (v[j][2] * v[j][2] + v[j][3] * v[j][3]); }
            const float rs = rsqrtf(wave_sum(s) * (1.0f / DM) + NEPS);
#pragma unroll
            for (int j = 0; j < 4; ++j) { const f32x4 o = v[j] * rs * wv[j]; u32x2 w; w.x = pk2(o[0], o[1]); w.y = pk2(o[2], o[3]); *(u32x2*)(XN + (size_t)t * DM + 4 * lane + 256 * j) = w; } }
    }
}
template <int CH> __device__ __forceinline__ void p2_rwkv_chunk(const Params& p, int t0, int lane) {
    unsigned char* ws = p.ws;
    const int chunk = lane + 64 * CH, c = chunk * 8;
    bf16_t* RKV = (bf16_t*)(ws + WS_RKV); bf16_t* AP = (bf16_t*)p.out; float* RINV = (float*)(ws + WS_RINV);
    if (CH == 3 && chunk >= 232) {
        if (chunk < 240) { const u32x4 zero = {0u, 0u, 0u, 0u};
#pragma unroll 4
            for (int i = 0; i < 16; ++i) *(u32x4*)(AP + (size_t)(t0 + i) * KLORA + 320 + (chunk - 232) * 8) = zero; }
        return; }
    const bf16_t* zc = (const bf16_t*)(ws + WS_Z) + (size_t)t0 * ZLD + c;
    float mu[8], kq[8];
    { const f32x4 m0 = *(const f32x4*)(p.in[8] + c), m1 = *(const f32x4*)(p.in[8] + c + 4);
#pragma unroll
      for (int i = 0; i < 4; ++i) { mu[i] = m0[i]; mu[4 + i] = m1[i]; } }
    if (CH == 1) { const f32x4 q0 = *(const f32x4*)(p.in[14] + c - 512), q1 = *(const f32x4*)(p.in[14] + c - 512 + 4);
#pragma unroll
        for (int i = 0; i < 4; ++i) { kq[i] = q0[i]; kq[4 + i] = q1[i]; } }
    float P[8], C[8], N[8];
    if ((t0 & (T_SEQ - 1)) != 0) unpack8(__builtin_nontemporal_load((const u32x4*)(zc - ZLD)), P); else {
#pragma unroll
        for (int i = 0; i < 8; ++i) P[i] = 0.f; }
    unpack8(__builtin_nontemporal_load((const u32x4*)(zc)), C);
    u32x4 raw = __builtin_nontemporal_load((const u32x4*)(zc + ZLD));
#pragma unroll 2
    for (int i = 0; i < 16; ++i) {
        const int t = t0 + i; const bool hasn = (t & (T_SEQ - 1)) != T_SEQ - 1;
        if (hasn) unpack8(raw, N); else {
#pragma unroll
            for (int q = 0; q < 8; ++q) N[q] = 0.f; }
        if (i < 15 && ((t + 1) & (T_SEQ - 1)) != T_SEQ - 1) raw = __builtin_nontemporal_load((const u32x4*)(zc + (size_t)(i + 2) * ZLD));
        float zs[8];
#pragma unroll
        for (int q = 0; q < 8; ++q) zs[q] = C[q] + mu[q] * (0.5f * (P[q] + N[q]) - C[q]);
        if (CH < 3) {
            *(u32x4*)(RKV + (size_t)t * 1536 + c) = pack8(zs);
            if (CH == 1) { float s2 = 0.f;
#pragma unroll
                for (int q = 0; q < 8; ++q) { const float v = zs[q] * kq[q]; s2 += v * v; }
                s2 = red8s(s2);
                if ((lane & 7) == 0) RINV[t * 8 + (lane >> 3)] = rsqrtf(fmaxf(s2, 1e-24f)); }
        } else {
            const int cc = c - 1536; float o[8];
#pragma unroll
            for (int q = 0; q < 8; ++q) o[q] = cc < 128 ? tanhf_(zs[q]) : (cc < 192 ? zs[q] : sigmoidf_(zs[q]));
            *(u32x4*)(AP + (size_t)t * KLORA + cc) = pack8(o);
        }
#pragma unroll
        for (int q = 0; q < 8; ++q) { P[q] = C[q]; C[q] = N[q]; }
    }
}
template <int CH> __device__ __forceinline__ void p2_gla_chunk(const Params& p, int t0, int lane) {
    unsigned char* ws = p.ws;
    const int c = (lane + 64 * CH) * 8; const float sc = c < 256 ? 0.125f : 1.0f;
    bf16_t* GQKV = (bf16_t*)(ws + WS_GQKV);
    const bf16_t* zc = (const bf16_t*)(ws + WS_Z) + (size_t)t0 * ZLD + NRW + c;
    float w0[8], w1[8], w2[8];
#pragma unroll
    for (int h = 0; h < 2; ++h) { const f32x4 a = *(const f32x4*)(p.in[19] + c + 4 * h), b = *(const f32x4*)(p.in[19] + 1024 + c + 4 * h), d = *(const f32x4*)(p.in[19] + 2048 + c + 4 * h);
#pragma unroll
        for (int i = 0; i < 4; ++i) { w0[4 * h + i] = a[i]; w1[4 * h + i] = b[i]; w2[4 * h + i] = d[i]; } }
    float P[8], C[8], N[8];
    if ((t0 & (T_SEQ - 1)) != 0) unpack8(__builtin_nontemporal_load((const u32x4*)(zc - ZLD)), P); else {
#pragma unroll
        for (int i = 0; i < 8; ++i) P[i] = 0.f; }
    unpack8(__builtin_nontemporal_load((const u32x4*)(zc)), C);
    u32x4 raw = __builtin_nontemporal_load((const u32x4*)(zc + ZLD));
#pragma unroll 2
    for (int i = 0; i < 16; ++i) {
        const int t = t0 + i; const bool hasn = (t & (T_SEQ - 1)) != T_SEQ - 1;
        if (hasn) unpack8(raw, N); else {
#pragma unroll
            for (int q = 0; q < 8; ++q) N[q] = 0.f; }
        if (i < 15 && ((t + 1) & (T_SEQ - 1)) != T_SEQ - 1) raw = __builtin_nontemporal_load((const u32x4*)(zc + (size_t)(i + 2) * ZLD));
        float o[8];
#pragma unroll
        for (int q = 0; q < 8; ++q) { const float y = w0[q] * P[q] + w1[q] * C[q] + w2[q] * N[q]; o[q] = siluf_(y) * sc; }
        *(u32x4*)(GQKV + (size_t)t * 1024 + c) = pack8(o);
#pragma unroll
        for (int q = 0; q < 8; ++q) { P[q] = C[q]; C[q] = N[q]; }
    }
}
__device__ __forceinline__ void p2_gate(const Params& p, const LAS float* aup, int t0, int lane) {
    unsigned char* ws = p.ws; bf16_t* GNL = (bf16_t*)(ws + WS_GNL); bf16_t* GG = (bf16_t*)(ws + WS_GG); const float* ab = p.in[21];
    const f32x4 ab0 = *(const f32x4*)(ab + 4 * lane), ab1 = *(const f32x4*)(ab + 256 + 4 * lane);
#pragma unroll 2
    for (int i = 0; i < 16; ++i) {
        const int t = t0 + i; const bf16_t* zg = (const bf16_t*)(ws + WS_Z) + (size_t)t * ZLD + NRW;
        __builtin_nontemporal_store(__builtin_nontemporal_load((const u32x4*)(zg + 1024 + lane * 8)), (u32x4*)(GG + (size_t)t * 512 + lane * 8));
        const unsigned short araw = zg[1536 + (lane & 31)]; const int alo = (int)((unsigned)araw << 16);
        f32x4 acc0 = ab0, acc1 = ab1;
#pragma unroll
        for (int r = 0; r < 16; ++r) { const float a0 = __int_as_float(__builtin_amdgcn_readlane(alo, r)), a1 = __int_as_float(__builtin_amdgcn_readlane(alo, 16 + r));
            acc0 += a0 * *(const LAS f32x4*)(aup + r * 256 + 4 * lane); acc1 += a1 * *(const LAS f32x4*)(aup + (16 + r) * 256 + 4 * lane); }
        float n0[4], n1[4];
#pragma unroll
        for (int j = 0; j < 4; ++j) { const float y0 = -acc0[j], y1 = -acc1[j];
            n0[j] = (fmaxf(y0, 0.f) + __logf(1.0f + __expf(-fabsf(y0)))) * 0.0625f; n1[j] = (fmaxf(y1, 0.f) + __logf(1.0f + __expf(-fabsf(y1)))) * 0.0625f; }
        u32x2 w; w.x = pk2(n0[0], n0[1]); w.y = pk2(n0[2], n0[3]); *(u32x2*)(GNL + (size_t)t * 512 + 4 * lane) = w;
        w.x = pk2(n1[0], n1[1]); w.y = pk2(n1[2], n1[3]); *(u32x2*)(GNL + (size_t)t * 512 + 256 + 4 * lane) = w;
    }
}
__device__ __forceinline__ void phase2(const Params& p, LAS unsigned char* lds, int wid, int lane) {
    const float* aupg = p.in[20];
    LAS float* aup = (LAS float*)lds;
    for (int i = threadIdx.x; i < 2 * 16 * 256; i += 512) aup[i] = aupg[i];
    __syncthreads();
    const int gw = blockIdx.x * 8 + wid, NGW = gridDim.x * 8;
    for (int grp = gw; grp < M_TOK / 16; grp += NGW) {
        const int t0 = grp * 16;
        p2_rwkv_chunk<0>(p, t0, lane); p2_rwkv_chunk<1>(p, t0, lane); p2_rwkv_chunk<2>(p, t0, lane); p2_rwkv_chunk<3>(p, t0, lane);
        p2_gla_chunk<0>(p, t0, lane); p2_gla_chunk<1>(p, t0, lane);
        p2_gate(p, aup, t0, lane);
    }
}
constexpr int SC_CH = 16;
constexpr int SB_XA = 0, SB_XB = 4608, SB_XBT = 9216, SB_VT = 14336, SB_WE = 17408, SC_BUF = 17664;
constexpr int SW_GR = 0, SW_HT = 1024, SW_GYT = 2560, SW_TIT = 4096, SW_SIZE = 5632, SC_IMG = 4 * SC_BUF;
typedef float f32x16 __attribute__((ext_vector_type(16)));
typedef __bf16 bf16x2_t __attribute__((ext_vector_type(2)));
__device__ __forceinline__ unsigned cvt2(float a, float b) { f32x2 v = {a, b}; bf16x2_t r = __builtin_convertvector(v, bf16x2_t); return __builtin_bit_cast(unsigned, r); }
__device__ __forceinline__ bf16x8 pack8r(float a, float b, float c, float d, float e, float f, float g, float hh) { u32x4 p; p.x = cvt2(a, b); p.y = cvt2(c, d); p.z = cvt2(e, f); p.w = cvt2(g, hh); return __builtin_bit_cast(bf16x8, p); }
#define MFMA32(a, b, c) __builtin_amdgcn_mfma_f32_32x32x16_bf16((a), (b), (c), 0, 0, 0)
struct ScanSrc { const bf16_t* v[6]; int ld[6]; bf16_t* out; int rev; int tokbase; };
struct ScanLd { u32x2 rd, rk, rr, rv, rkk, rnb; };
template <bool RWKV> __device__ __forceinline__ void scan_load_issue(ScanLd& L, const ScanSrc& S, int chunk, int lt) {
    const int lw = lt >> 6, lane = lt & 63, sl = lane >> 2, col = 16 * lw + 4 * (lane & 3), s = chunk * SC_CH + sl; const size_t tok = (size_t)(S.tokbase + (S.rev ? T_SEQ - 1 - s : s));
    L.rd = *(const u32x2*)(S.v[0] + tok * S.ld[0] + col); L.rk = *(const u32x2*)(S.v[1] + tok * S.ld[1] + col); L.rr = *(const u32x2*)(S.v[4] + tok * S.ld[4] + col); L.rv = *(const u32x2*)(S.v[5] + tok * S.ld[5] + col);
    L.rkk = L.rk; L.rnb = L.rk;
    if (RWKV) { L.rkk = *(const u32x2*)(S.v[2] + tok * S.ld[2] + col); L.rnb = *(const u32x2*)(S.v[3] + tok * S.ld[3] + col); }
}
template <bool RWKV> __device__ __forceinline__ void scan_load_finish(LAS unsigned char* buf, const ScanLd& L, int lt) {
    const int lw = lt >> 6, lane = lt & 63, sl = lane >> 2, col = 16 * lw + 4 * (lane & 3);
    float d[4], c[4], k[4], r[4], v[4], kk[4], nb[4];
    unpack4(L.rd, d); unpack4(L.rk, k); unpack4(L.rr, r); unpack4(L.rv, v); unpack4(L.rkk, kk); unpack4(L.rnb, nb);
#pragma unroll
    for (int i = 0; i < 4; ++i) c[i] = d[i];
#pragma unroll
    for (int dl = 4; dl < 64; dl <<= 1)
#pragma unroll
        for (int i = 0; i < 4; ++i) { const float t = __shfl_up(c[i], dl); c[i] += (lane >= dl) ? t : 0.f; }
    float o1[4], o2[4], o3[4], o4[4]; f32x4 we;
#pragma unroll
    for (int i = 0; i < 4; ++i) { const float W = __expf(-c[i]), iW = __expf(c[i]), Wp = __expf(d[i] - c[i]); o1[i] = RWKV ? kk[i] * Wp : 0.f; o2[i] = RWKV ? nb[i] * iW : 0.f; o3[i] = k[i] * iW; o4[i] = r[i] * W; we[i] = W; }
    u32x2 w;
    w.x = cvt2(o1[0], o1[1]); w.y = cvt2(o1[2], o1[3]); *(LAS u32x2*)(buf + SB_XA + sl * 144 + col * 2) = w;
    w.x = cvt2(o4[0], o4[1]); w.y = cvt2(o4[2], o4[3]); *(LAS u32x2*)(buf + SB_XA + (16 + sl) * 144 + col * 2) = w;
    w.x = cvt2(o2[0], o2[1]); w.y = cvt2(o2[2], o2[3]); *(LAS u32x2*)(buf + SB_XB + sl * 144 + col * 2) = w;
    w.x = cvt2(o3[0], o3[1]); w.y = cvt2(o3[2], o3[3]); *(LAS u32x2*)(buf + SB_XB + (16 + sl) * 144 + col * 2) = w;
#pragma unroll
    for (int i = 0; i < 4; ++i) {
        *(LAS unsigned short*)(buf + SB_XBT + (col + i) * 80 + sl * 2) = (unsigned short)(cvt2(o2[i], 0.f) & 0xffffu);
        *(LAS unsigned short*)(buf + SB_XBT + (col + i) * 80 + (16 + sl) * 2) = (unsigned short)(cvt2(o3[i], 0.f) & 0xffffu);
        *(LAS unsigned short*)(buf + SB_VT + (col + i) * 48 + sl * 2) = (unsigned short)(cvt2(v[i], 0.f) & 0xffffu); }
    if (sl == SC_CH - 1) *(LAS f32x4*)(buf + SB_WE + col * 4) = we;
}
template <bool RWKV> __device__ __forceinline__ void scan_prep_m1(const LAS unsigned char* buf, LAS unsigned char* img, int lane) {
    const int r = lane & 31, h = lane >> 5;
    f32x16 gh;
#pragma unroll
    for (int i = 0; i < 16; ++i) gh[i] = 0.f;
#pragma unroll
    for (int kb = 0; kb < 4; ++kb) { const bf16x8 a = *(const LAS bf16x8*)(buf + SB_XB + r * 144 + (16 * kb + 8 * h) * 2), b = *(const LAS bf16x8*)(buf + SB_XA + r * 144 + (16 * kb + 8 * h) * 2); gh = MFMA32(a, b, gh); }
    const int lim = r < 16 ? r : r - 15;
#pragma unroll
    for (int g = 0; g < 2; ++g) { const int t0 = 8 * g + 4 * h; float x[4], y[4];
#pragma unroll
        for (int q = 0; q < 4; ++q) { x[q] = (t0 + q < lim) ? gh[4 * g + q] : 0.f; y[q] = (t0 + q < lim) ? gh[8 + 4 * g + q] : 0.f; }
        if (RWKV && r < 16) {
#pragma unroll
            for (int q = 0; q < 4; ++q) *(LAS float*)(img + SW_GR + ((t0 + q) * 16 + r) * 4) = x[q]; }
        u32x2 wv; wv.x = r >= 16 ? cvt2(x[0], x[1]) : 0u; wv.y = r >= 16 ? cvt2(x[2], x[3]) : 0u; *(LAS u32x2*)(img + SW_GYT + r * 48 + t0 * 2) = wv;
        wv.x = cvt2(y[0], y[1]); wv.y = cvt2(y[2], y[3]); *(LAS u32x2*)(img + SW_HT + r * 48 + t0 * 2) = wv; }
}
template <bool RWKV> __device__ __forceinline__ void scan_prep_inv(LAS unsigned char* img, int lane) {
    const int r = lane & 31;
    if (RWKV) {
        const int sc = lane & 15; float X[16];
#pragma unroll
        for (int t = 15; t >= 0; --t) { float acc = (t == sc) ? 1.f : 0.f;
#pragma unroll
            for (int m4 = (t + 1) / 4; m4 < 4; ++m4) { const f32x4 gv = *(const LAS f32x4*)(img + SW_GR + (t * 16 + 4 * m4) * 4);
#pragma unroll
                for (int q = 0; q < 4; ++q) if (4 * m4 + q > t) acc = fmaf(gv[q], X[4 * m4 + q], acc); }
            X[t] = acc; }
        if (lane < 32) { u32x4 p0, p1; const bool z = r >= 16;
            p0.x = z ? 0u : cvt2(X[0], X[1]); p0.y = z ? 0u : cvt2(X[2], X[3]); p0.z = z ? 0u : cvt2(X[4], X[5]); p0.w = z ? 0u : cvt2(X[6], X[7]);
            p1.x = z ? 0u : cvt2(X[8], X[9]); p1.y = z ? 0u : cvt2(X[10], X[11]); p1.z = z ? 0u : cvt2(X[12], X[13]); p1.w = z ? 0u : cvt2(X[14], X[15]);
            *(LAS u32x4*)(img + SW_TIT + r * 48) = p0; *(LAS u32x4*)(img + SW_TIT + r * 48 + 16) = p1; }
    }
}
__device__ __forceinline__ bf16x8 lds_aperm(const LAS unsigned char* rowp, int h) {
    const u32x2 a0 = *(const LAS u32x2*)(rowp + 8 * h), a1 = *(const LAS u32x2*)(rowp + 16 + 8 * h); u32x4 aa; aa.x = a0.x; aa.y = a0.y; aa.z = a1.x; aa.w = a1.y; return __builtin_bit_cast(bf16x8, aa);
}
template <bool RWKV> __device__ __forceinline__ void scan_chunk(const LAS unsigned char* buf, const LAS unsigned char* img, f32x16 (&T)[2], const ScanSrc& S, int chunk, int w, int lane) {
    const int r = lane & 31, h = lane >> 5;
    f32x16 zero;
#pragma unroll
    for (int i = 0; i < 16; ++i) zero[i] = 0.f;
    const bf16x8 vb = *(const LAS bf16x8*)(buf + SB_VT + (32 * w + r) * 48 + 16 * h);
    f32x16 ry = zero, ry2 = zero;
#pragma unroll
    for (int kb = 0; kb < 2; ++kb) {
        const bf16x8 b0 = pack8r(T[0][8 * kb], T[0][8 * kb + 1], T[0][8 * kb + 2], T[0][8 * kb + 3], T[0][8 * kb + 4], T[0][8 * kb + 5], T[0][8 * kb + 6], T[0][8 * kb + 7]);
        const bf16x8 b1 = pack8r(T[1][8 * kb], T[1][8 * kb + 1], T[1][8 * kb + 2], T[1][8 * kb + 3], T[1][8 * kb + 4], T[1][8 * kb + 5], T[1][8 * kb + 6], T[1][8 * kb + 7]);
        ry = MFMA32(lds_aperm(buf + SB_XA + r * 144 + (16 * kb) * 2, h), b0, ry);
        ry2 = MFMA32(lds_aperm(buf + SB_XA + r * 144 + (32 + 16 * kb) * 2, h), b1, ry2); }
    { const bf16x8 a = *(const LAS bf16x8*)(img + SW_HT + r * 48 + 16 * h); ry = MFMA32(a, vb, ry); }
#pragma unroll
    for (int i = 0; i < 16; ++i) ry[i] += ry2[i];
    bf16x8 ub;
    if (RWKV) {
        const bf16x8 rb = pack8r(ry[0], ry[1], ry[2], ry[3], ry[4], ry[5], ry[6], ry[7]);
        const f32x16 ua = MFMA32(lds_aperm(img + SW_TIT + r * 48, h), rb, zero);
        ub = pack8r(ua[0], ua[1], ua[2], ua[3], ua[4], ua[5], ua[6], ua[7]);
        ry = MFMA32(lds_aperm(img + SW_GYT + r * 48, h), ub, ry);
    }
    {
        const int s0 = chunk * SC_CH; const long tok0 = (long)S.tokbase + (S.rev ? T_SEQ - 1 - s0 : s0), dstep = S.rev ? -512 : 512;
        bf16_t* op = S.out + tok0 * 512 + 32 * w + r;
#pragma unroll
        for (int q = 8; q < 16; ++q) { const int s = (q & 3) + 8 * ((q >> 2) - 2) + 4 * h; op[s * dstep] = (bf16_t)(cvt2(ry[q], 0.f) & 0xffffu); }
    }
#pragma unroll
    for (int jt = 0; jt < 2; ++jt) {
        if (RWKV) T[jt] = MFMA32(lds_aperm(buf + SB_XBT + (32 * jt + r) * 80, h), ub, T[jt]);
        { const bf16x8 a = *(const LAS bf16x8*)(buf + SB_XBT + (32 * jt + r) * 80 + 32 + 16 * h); T[jt] = MFMA32(a, vb, T[jt]); }
#pragma unroll
        for (int g = 0; g < 4; ++g) { const f32x4 we = *(const LAS f32x4*)(buf + SB_WE + (32 * jt + 8 * g + 4 * h) * 4);
#pragma unroll
            for (int q = 0; q < 4; ++q) T[jt][4 * g + q] *= we[q]; }
    }
}
template <bool RWKV> __device__ __forceinline__ void scan_item(LAS unsigned char* lds, const ScanSrc& S, int wid, int lane) {
    f32x16 T[2];
#pragma unroll
    for (int a = 0; a < 2; ++a)
#pragma unroll
        for (int i = 0; i < 16; ++i) T[a][i] = 0.f;
    const bool is_ld = (wid == 4) | (wid == 5) | (wid == 3) | (wid == 7); const bool is_prep = wid == 2;
    const int lt = (wid == 4 ? 0 : wid == 5 ? 64 : wid == 3 ? 128 : 192) + lane;
    ScanLd L;
    constexpr int NCH = T_SEQ / SC_CH;
#define SC_BAR() do { asm volatile("s_waitcnt lgkmcnt(0)" ::: "memory"); __builtin_amdgcn_s_barrier(); asm volatile("" ::: "memory"); } while (0)
    const bool is_inv = wid == 6;
    if (is_ld) { scan_load_issue<RWKV>(L, S, 0, lt); scan_load_finish<RWKV>(lds, L, lt); scan_load_issue<RWKV>(L, S, 1, lt); scan_load_finish<RWKV>(lds + SC_BUF, L, lt);
                 scan_load_issue<RWKV>(L, S, 2, lt); scan_load_finish<RWKV>(lds + 2 * SC_BUF, L, lt); scan_load_issue<RWKV>(L, S, 3, lt); }
    __syncthreads();
    if (is_prep) { scan_prep_m1<RWKV>(lds, lds + SC_IMG, lane); scan_prep_m1<RWKV>(lds + SC_BUF, lds + SC_IMG + SW_SIZE, lane); }
    SC_BAR();
    if (is_inv) scan_prep_inv<RWKV>(lds + SC_IMG, lane);
    SC_BAR();
    int b0 = 0, i0 = 0;
    for (int c = 0; c < NCH; ++c) {
        const int i1 = i0 == 2 ? 0 : i0 + 1, i2 = i1 == 2 ? 0 : i1 + 1;
        if (is_ld) {
            if (c + 3 < NCH) scan_load_finish<RWKV>(lds + ((b0 + 3) & 3) * SC_BUF, L, lt);
            if (c + 4 < NCH) scan_load_issue<RWKV>(L, S, c + 4, lt); }
        else if (is_prep) { if (c + 2 < NCH) scan_prep_m1<RWKV>(lds + ((b0 + 2) & 3) * SC_BUF, lds + SC_IMG + i2 * SW_SIZE, lane); }
        else if (is_inv) { if (c + 1 < NCH) scan_prep_inv<RWKV>(lds + SC_IMG + i1 * SW_SIZE, lane); }
        else if (wid < 2) scan_chunk<RWKV>(lds + b0 * SC_BUF, lds + SC_IMG + i0 * SW_SIZE, T, S, c, wid, lane);
        SC_BAR();
        b0 = (b0 + 1) & 3; i0 = i1;
    }
#undef SC_BAR
}
__device__ __forceinline__ void phase3(const Params& p, LAS unsigned char* lds, int wid, int lane) {
    unsigned char* ws = p.ws; bf16_t* yo = (bf16_t*)p.out;
    const bf16_t* RKV = (const bf16_t*)(ws + WS_RKV); const bf16_t* KK = (const bf16_t*)(ws + WS_KK); const bf16_t* NB = (const bf16_t*)(ws + WS_NB);
    const bf16_t* DFp = (const bf16_t*)(ws + WS_DF); const bf16_t* DBp = (const bf16_t*)(ws + WS_DB);
    const bf16_t* GQKV = (const bf16_t*)(ws + WS_GQKV); const bf16_t* GNL = (const bf16_t*)(ws + WS_GNL);
    for (int item = blockIdx.x; item < 256; item += gridDim.x) {
        ScanSrc S;
        if (item < 128) {
            const int dir = item & 1, h = (item >> 1) & 7, b = item >> 4;
            S.v[0] = (dir ? DBp : DFp) + h * 64; S.ld[0] = 512; S.v[1] = RKV + 512 + h * 64; S.ld[1] = 1536; S.v[2] = KK + h * 64; S.ld[2] = 512; S.v[3] = NB + h * 64; S.ld[3] = 512;
            S.v[4] = RKV + h * 64; S.ld[4] = 1536; S.v[5] = RKV + 1024 + h * 64; S.ld[5] = 1536;
            S.out = yo + (size_t)dir * M_TOK * 512 + h * 64; S.rev = dir; S.tokbase = b * T_SEQ;
            scan_item<true>(lds, S, wid, lane);
        } else {
            const int i2 = item - 128, half = i2 & 1, dir = (i2 >> 1) & 1, h = (i2 >> 2) & 3, b = i2 >> 4;
            S.v[0] = GNL + dir * 256 + h * 64; S.ld[0] = 512; S.v[1] = GQKV + 256 + h * 64; S.ld[1] = 1024; S.v[2] = S.v[1]; S.ld[2] = 0; S.v[3] = S.v[1]; S.ld[3] = 0;
            S.v[4] = GQKV + h * 64; S.ld[4] = 1024; S.v[5] = GQKV + 512 + h * 128 + half * 64; S.ld[5] = 1024;
            S.out = yo + (size_t)(2 + dir) * M_TOK * 512 + h * 128 + half * 64; S.rev = dir; S.tokbase = b * T_SEQ;
            scan_item<false>(lds, S, wid, lane);
        }
        __syncthreads();
    }
}
__device__ __forceinline__ void phase4(const Params& p, int wid, int lane) {
    unsigned char* ws = p.ws; const bf16_t* yo = (const bf16_t*)p.out;
    const bf16_t* RKV = (const bf16_t*)(ws + WS_RKV); const bf16_t* G = (const bf16_t*)(ws + WS_G); const bf16_t* GG = (const bf16_t*)(ws + WS_GG); bf16_t* YM = (bf16_t*)(ws + WS_YMIX);
    const int c = lane * 8;
    float rk[8], lw[8], lb[8], gn[8];
#pragma unroll
    for (int i = 0; i < 8; ++i) { rk[i] = p.in[16][c + i]; lw[i] = p.in[17][c + i]; lb[i] = p.in[18][c + i]; gn[i] = p.in[22][(c + i) & 127]; }
    const int gw = blockIdx.x * 8 + wid, NGW = gridDim.x * 8;
    for (int t = gw; t < M_TOK; t += NGW) {
        const size_t o5 = (size_t)t * 512 + c;
        {
            float yf[8], yb[8], y[8], r[8], k[8], v[8], g[8];
            unpack8(__builtin_nontemporal_load((const u32x4*)(yo + o5)), yf); unpack8(__builtin_nontemporal_load((const u32x4*)(yo + (size_t)M_TOK * 512 + o5)), yb);
            unpack8(__builtin_nontemporal_load((const u32x4*)(RKV + (size_t)t * 1536 + c)), r); unpack8(__builtin_nontemporal_load((const u32x4*)(RKV + (size_t)t * 1536 + 512 + c)), k); unpack8(__builtin_nontemporal_load((const u32x4*)(RKV + (size_t)t * 1536 + 1024 + c)), v);
            unpack8(__builtin_nontemporal_load((const u32x4*)(G + o5)), g);
            float s = 0.f, bsum = 0.f;
#pragma unroll
            for (int i = 0; i < 8; ++i) { y[i] = yf[i] + yb[i]; s += y[i]; bsum += r[i] * k[i] * rk[i]; }
            s = red8s(s); bsum = red8s(bsum);
            const float mean = s * (1.0f / 64.0f); float q = 0.f;
#pragma unroll
            for (int i = 0; i < 8; ++i) { y[i] -= mean; q += y[i] * y[i]; }
            q = red8s(q);
            const float rstd = rsqrtf(q * (1.0f / 64.0f) + 64e-5f); float o[8];
#pragma unroll
            for (int i = 0; i < 8; ++i) o[i] = (y[i] * rstd * lw[i] + lb[i] + bsum * v[i]) * g[i];
            *(u32x4*)(YM + (size_t)t * DM + c) = pack8(o);
        }
        {
            float of[8], ob[8], o[8], g[8];
            unpack8(__builtin_nontemporal_load((const u32x4*)(yo + (size_t)2 * M_TOK * 512 + o5)), of); unpack8(__builtin_nontemporal_load((const u32x4*)(yo + (size_t)3 * M_TOK * 512 + o5)), ob); unpack8(__builtin_nontemporal_load((const u32x4*)(GG + o5)), g);
            float q = 0.f;
#pragma unroll
            for (int i = 0; i < 8; ++i) { o[i] = of[i] + ob[i]; q += o[i] * o[i]; }
            q = red16s(q);
            const float rs = rsqrtf(q * (1.0f / 128.0f) + NEPS); float r[8];
#pragma unroll
            for (int i = 0; i < 8; ++i) r[i] = o[i] * rs * gn[i] * siluf_(g[i]);
            *(u32x4*)(YM + (size_t)t * DM + 512 + c) = pack8(r);
        }
    }
}
template <int MODE> __device__ __forceinline__ void phase_row(const void* basev, const bf16_t* add, const float* ss, const float* wpost, const float* wpre, void* outv, bf16_t* HB, int wid, int lane) {
    float wp[2][8], wq[2][8];
#pragma unroll
    for (int j = 0; j < 2; ++j)
#pragma unroll
        for (int i = 0; i < 8; ++i) { wp[j][i] = wpost[8 * lane + 512 * j + i]; wq[j][i] = MODE == 0 ? wpre[8 * lane + 512 * j + i] : 1.f; }
    const int gw = blockIdx.x * 8 + wid, NGW = gridDim.x * 8;
    for (int t = gw; t < M_TOK; t += NGW) {
        const size_t off = (size_t)t * DM + 8 * lane; const float rs = rsqrtf(ss[t] * (1.0f / DM) + NEPS); float h[2][8]; float s = 0.f;
#pragma unroll
        for (int j = 0; j < 2; ++j) { float b[8], a[8];
            if (MODE == 0) { const f32x4 b0 = __builtin_nontemporal_load((const f32x4*)((const float*)basev + off + 512 * j)), b1 = __builtin_nontemporal_load((const f32x4*)((const float*)basev + off + 512 * j + 4));
#pragma unroll
                for (int i = 0; i < 4; ++i) { b[i] = b0[i]; b[4 + i] = b1[i]; } }
            else unpack8(__builtin_nontemporal_load((const u32x4*)((const bf16_t*)basev + off + 512 * j)), b);
            unpack8(__builtin_nontemporal_load((const u32x4*)(add + off + 512 * j)), a);
#pragma unroll
            for (int i = 0; i < 8; ++i) { h[j][i] = b[i] + a[i] * rs * wp[j][i]; s += h[j][i] * h[j][i]; } }
        if (MODE == 2) {
#pragma unroll
            for (int j = 0; j < 2; ++j) { float* o = (float*)outv + off + 512 * j; __builtin_nontemporal_store((f32x4){h[j][0], h[j][1], h[j][2], h[j][3]}, (f32x4*)o); __builtin_nontemporal_store((f32x4){h[j][4], h[j][5], h[j][6], h[j][7]}, (f32x4*)(o + 4)); }
        } else {
#pragma unroll
            for (int j = 0; j < 2; ++j) { if (MODE == 0) __builtin_nontemporal_store(pack8(h[j]), (u32x4*)((bf16_t*)outv + off + 512 * j)); else *(u32x4*)((bf16_t*)outv + off + 512 * j) = pack8(h[j]); }
        }
        if (MODE == 0) { const float r2 = rsqrtf(wave_sum(s) * (1.0f / DM) + NEPS);
#pragma unroll
            for (int j = 0; j < 2; ++j) { float o[8];
#pragma unroll
                for (int i = 0; i < 8; ++i) o[i] = h[j][i] * r2 * wq[j][i];
                *(u32x4*)(HB + off + 512 * j) = pack8(o); } }
    }
}
__global__ void __launch_bounds__(512, 2) hymba_fwd(Params p) {
    extern __shared__ __attribute__((aligned(16))) unsigned char lds_raw[];
    LAS unsigned char* lds = (LAS unsigned char*)lds_raw;
    cg::grid_group grid = cg::this_grid();
    volatile LAS unsigned* stw = (volatile LAS unsigned*)(lds + 131072);
    if (threadIdx.x == 0) { stw[0] = 0u; stw[1] = 0u; }
    __syncthreads();
    const XcdBarrier xbar = xcd_barrier_post((unsigned*)(p.ws + WS_BAR), stw);
    int wid, lane;
#define GETWL() do { int t_ = threadIdx.x; asm volatile("" : "+v"(t_)); wid = __builtin_amdgcn_readfirstlane(t_ >> 6); lane = t_ & 63; } while (0)
    unsigned char* ws = p.ws; const int G = gridDim.x, c = blockIdx.x;
    float* SS = (float*)(ws + WS_SS);
    GETWL();
    phase0(p, lds, wid, lane);
    if (p.ws == nullptr) grid.sync();
    xcd_barrier(xbar);
    {
        Gemm g{(const bf16_t*)(ws + WS_XN), (const bf16_t*)(ws + WS_W1T), M_TOK, ZLD, DM}; StaticOrder S; S.init(M_TOK, ZLD, G, c);
        EpiBf16Plain E{(bf16_t*)(ws + WS_Z), ZLD}; gemm_phase<EpiBf16Plain, StaticOrder>(lds, g, S, E); }
    xcd_barrier(xbar);
    GETWL();
    phase2(p, lds, wid, lane);
    xcd_barrier(xbar);
    {
        Gemm g{(const bf16_t*)p.out, (const bf16_t*)(ws + WS_W2T), M_TOK, 1024, KLORA}; StaticOrder S; S.init(M_TOK, 1024, G, c);
        EpiLoraW E{p.in[9], (bf16_t*)(ws + WS_DF), (bf16_t*)(ws + WS_DB)}; gemm_phase<EpiLoraW, StaticOrder>(lds, g, S, E);
        Gemm g2{(const bf16_t*)p.out, (const bf16_t*)(ws + WS_W2T) + (size_t)1024 * KLORA, M_TOK, 1024, KLORA};
        EpiLoraAG E2{p.in[11], p.in[14], p.in[15], (const float*)(ws + WS_RINV), (bf16_t*)(ws + WS_RKV), (bf16_t*)(ws + WS_KK), (bf16_t*)(ws + WS_NB), (bf16_t*)(ws + WS_G)};
        gemm_phase<EpiLoraAG, StaticOrder>(lds, g2, S, E2); }
    xcd_barrier(xbar);
    GETWL();
    phase3(p, lds, wid, lane);
    xcd_barrier(xbar);
    GETWL();
    phase4(p, wid, lane);
    xcd_barrier(xbar);
    {
        Gemm g{(const bf16_t*)(ws + WS_YMIX), (const bf16_t*)(ws + WS_W3T), M_TOK, DM, DM}; StaticOrder S; S.init(M_TOK, DM, G, c);
        EpiBf16SS E{(bf16_t*)(ws + WS_Y), DM, SS}; gemm_phase<EpiBf16SS, StaticOrder>(lds, g, S, E); }
    xcd_barrier(xbar);
    GETWL();
    phase_row<0>(p.in[0], (const bf16_t*)(ws + WS_Y), SS, p.in[3], p.in[4], ws + WS_H1, (bf16_t*)(ws + WS_HN), wid, lane);
    xcd_barrier(xbar);
    {
        Gemm g{(const bf16_t*)(ws + WS_HN), (const bf16_t*)(ws + WS_W4T), M_TOK, 2 * DFF, DM}; StaticOrder S; S.init(M_TOK, 2 * DFF, G, c);
        EpiSwiGLU E{(bf16_t*)(ws + WS_ACT)}; gemm_phase<EpiSwiGLU, StaticOrder>(lds, g, S, E); }
    xcd_barrier(xbar);
    {
        Gemm g{(const bf16_t*)(ws + WS_ACT), (const bf16_t*)(ws + WS_W5T), M_TOK, DM, DFF}; StaticOrder S; S.init(M_TOK, DM, G, c);
        EpiBf16SS E{(bf16_t*)p.out, DM, SS + M_TOK}; gemm_phase<EpiBf16SS, StaticOrder>(lds, g, S, E);
        Gemm g2{(const bf16_t*)(ws + WS_PB), (const bf16_t*)(ws + WS_W6T), M_TOK, DM, 256}; StaticOrder S2; S2.init(M_TOK, DM, G, c);
        EpiBf16Plain E2{(bf16_t*)(ws + WS_E), DM}; gemm_phase<EpiBf16Plain, StaticOrder>(lds, g2, S2, E2); }
    xcd_barrier(xbar);
    GETWL();
    phase_row<1>(ws + WS_H1, (const bf16_t*)p.out, SS + M_TOK, p.in[5], nullptr, ws + WS_HN, nullptr, wid, lane);
    xcd_barrier(xbar);
    {
        Gemm g{(const bf16_t*)(ws + WS_HN), (const bf16_t*)(ws + WS_W7T), M_TOK, DM, DM}; StaticOrder S; S.init(M_TOK, DM, G, c);
        EpiPleGate E{(bf16_t*)(ws + WS_Y), p.in[29], (const bf16_t*)(ws + WS_E), SS + 2 * M_TOK}; gemm_phase<EpiPleGate, StaticOrder>(lds, g, S, E); }
    xcd_barrier(xbar);
    GETWL();
    phase_row<2>(ws + WS_HN, (const bf16_t*)(ws + WS_Y), SS + 2 * M_TOK, p.in[6], nullptr, p.out, nullptr, wid, lane);
}
extern "C" void kernel_launch(void* const* d_in, const int* in_sizes, int n_in, void* d_out, int out_size, void* d_ws, size_t ws_size, hipStream_t stream) {
    constexpr size_t kLds = 131072 + 64;
    static int grid_blocks = 0;
    if (!grid_blocks) {
        int dev = 0, cus = 0, per_cu = 0;
        if (n_in != 30 || out_size != M_TOK * DM || ws_size < WS_END) { fprintf(stderr, "kernel_launch: unexpected shapes (n_in %d, out %d, ws %zu, need %zu)\n", n_in, out_size, ws_size, (size_t)WS_END); grid_blocks = -1; return; }
        (void)hipGetDevice(&dev);
        (void)hipDeviceGetAttribute(&cus, hipDeviceAttributeMultiprocessorCount, dev);
        (void)hipFuncSetAttribute((const void*)hymba_fwd, hipFuncAttributeMaxDynamicSharedMemorySize, (int)kLds);
        (void)hipOccupancyMaxActiveBlocksPerMultiprocessor(&per_cu, (const void*)hymba_fwd, 512, kLds);
        if (per_cu < 1) { fprintf(stderr, "kernel_launch: occupancy query reports %d blocks/CU\n", per_cu); grid_blocks = -1; return; }
        grid_blocks = cus;
    }
    if (grid_blocks < 0) return;
    (void)hipMemsetAsync((unsigned char*)d_ws + WS_BAR, 0, XCD_BAR_WORDS * 4, stream);
    Params p{};
    for (int i = 0; i < 30; ++i) p.in[i] = (const float*)d_in[i];
    p.out = (float*)d_out; p.ws = (unsigned char*)d_ws;
    void* args[] = {&p};
    hipError_t e = hipLaunchCooperativeKernel((const void*)hymba_fwd, dim3(grid_blocks), dim3(512), args, kLds, stream);
    if (e != hipSuccess) fprintf(stderr, "cooperative launch failed: %s (grid %d)\n", hipGetErrorString(e), grid_blocks);
}
```

```cpp
#include <hip/hip_runtime.h>
#include <hip/hip_cooperative_groups.h>
#include <cstdio>
namespace cg = cooperative_groups;
namespace pg8 {
#define PG8_LAS __attribute__((address_space(3)))
typedef unsigned short bf16_t;
typedef short bf16x8 __attribute__((ext_vector_type(8)));
typedef float f32x4 __attribute__((ext_vector_type(4)));
typedef float f32x2 __attribute__((ext_vector_type(2)));
typedef unsigned u32x4 __attribute__((ext_vector_type(4)));
typedef unsigned u32x2 __attribute__((ext_vector_type(2)));
constexpr int BM = 256, BK = 64, HALF = 128, HTB = HALF * BK * 2, STAGE_BYTES = 8 * HTB, NXCD = 8, WGM = 8;
__host__ __device__ __forceinline__ int lds_byte(int r, int c) { const int st = (r >> 4) * 2 + (c >> 5), rr = r & 15, cc = c & 31, ob = rr * 64 + cc * 2; return st * 1024 + (ob ^ (((ob >> 9) & 1) << 5)); }
__host__ __device__ __forceinline__ void stage_rc(int b, int& R, int& C) { const int st = b / 1024, sb = b % 1024, swz = sb ^ (((sb >> 9) & 1) << 5); R = (st >> 1) * 16 + swz / 64; C = (st & 1) * 32 + (swz % 64) / 2; }
__host__ __device__ __forceinline__ int perm32(int rho) { const int n = rho >> 4, i = rho & 15; return 8 * (i >> 2) + 4 * n + (i & 3); }
struct Unit { int pm, pn; };
struct Gemm { const bf16_t* A; const bf16_t* Bt; int M, N, K; };
struct StaticOrder {
    int nM, nN, nwg, G, c;
    __host__ __device__ void init(int M, int N, int G_, int c_) { nM = M / BM; nN = N / BM; nwg = nM * nN; G = G_; c = c_; }
    __host__ __device__ bool next(int i, Unit& u) const {
        const long L = (long)i * G + c; if (L >= nwg) return false;
        int wgid = (int)L; { const int q = nwg / NXCD, r = nwg % NXCD, xcd = wgid % NXCD, off = wgid / NXCD; wgid = (xcd < r ? xcd * (q + 1) : r * (q + 1) + (xcd - r) * q) + off; }
        const int nig = WGM * nN, gid = wgid / nig, fm = gid * WGM, gsz = (nM - fm) < WGM ? (nM - fm) : WGM;
        u.pm = fm + ((wgid % nig) % gsz); u.pn = (wgid % nig) / gsz; return true;
    }
    __device__ __forceinline__ void a_ready(const Unit&) const {}
    __device__ __forceinline__ void done(const Unit&) const {}
};
__device__ __forceinline__ unsigned cvt_pk_bf16(float lo, float hi) { unsigned r; asm volatile("v_cvt_pk_bf16_f32 %0, %1, %2" : "=v"(r) : "v"(lo), "v"(hi)); return r; }
template <class Epi, class Sched>
__device__ __forceinline__ void gemm_phase(PG8_LAS unsigned char* lds, const Gemm g, const Sched& S, const Epi& E) {
    int tid_ = threadIdx.x; asm volatile("" : "+v"(tid_));
    const int tid = tid_, wid = __builtin_amdgcn_readfirstlane(tid >> 6), lane = tid & 63, wr = wid >> 2, wc = wid & 3, fr = lane & 15, fq = lane >> 4;
    const int K = g.K, nt = K / BK;
    unsigned voffA[2], voffB[2];
#pragma unroll
    for (int i = 0; i < 2; ++i) { int R, C; stage_rc(tid * 16 + i * 8192, R, C); const int Rb = Epi::PERM ? ((R & ~31) + perm32(R & 31)) : R;
        voffA[i] = (unsigned)(R * K + C) * 2u; voffB[i] = (unsigned)(Rb * K + C) * 2u; }
    const size_t kstep = (size_t)(BK * 2);
    const size_t hstep = (size_t)HALF * K * 2;
    const size_t tstep = 2 * hstep;
    const unsigned ldsw = (unsigned)wid * 1024u;
    const int aoff = lds_byte(wr * 64 + fr, fq * 8), boff = lds_byte(wc * 32 + fr, fq * 8);
#define PG8_SA(b, h) (((b) * 2 + (h)) * HTB)
#define PG8_SB(b, h) ((4 + (b) * 2 + (h)) * HTB)
#define PG8_STAGE(bufoff, gbase, voff) do { _Pragma("unroll") for (int _i = 0; _i < 2; ++_i) \
        __builtin_amdgcn_global_load_lds((const unsigned*)((const char*)(gbase) + (voff)[_i]), (PG8_LAS unsigned*)(lds + (bufoff) + ldsw + _i * 8192), 16, 0, 0); } while (0)
#define PG8_LDA(dst, b, h) do { _Pragma("unroll") for (int m = 0; m < 4; ++m) _Pragma("unroll") for (int k = 0; k < 2; ++k) dst[m][k] = *(const PG8_LAS bf16x8*)(lds + PG8_SA(b, h) + aoff + m * 2048 + k * 1024); } while (0)
#define PG8_LDB(dst, b, h) do { _Pragma("unroll") for (int n = 0; n < 2; ++n) _Pragma("unroll") for (int k = 0; k < 2; ++k) dst[n][k] = *(const PG8_LAS bf16x8*)(lds + PG8_SB(b, h) + boff + n * 2048 + k * 1024); } while (0)
#define PG8_MMA(ai, bj, At, Bt) do { __builtin_amdgcn_s_setprio(1); _Pragma("unroll") for (int m = 0; m < 4; ++m) _Pragma("unroll") for (int n = 0; n < 2; ++n) _Pragma("unroll") for (int k = 0; k < 2; ++k) \
        acc[ai][bj][m][n] = __builtin_amdgcn_mfma_f32_16x16x32_bf16(Bt[n][k], At[m][k], acc[ai][bj][m][n], 0, 0, 0); __builtin_amdgcn_s_setprio(0); } while (0)
#define PG8_WAIT_V(n) asm volatile("s_waitcnt vmcnt(" #n ")" ::: "memory")
#define PG8_WAIT_L(n) asm volatile("s_waitcnt lgkmcnt(" #n ")" ::: "memory")
#define PG8_BAR __builtin_amdgcn_s_barrier()
#define PG8_SCHED __builtin_amdgcn_sched_barrier(0)
    Unit cur, nxt; int ui = 0;
    if (!S.next(0, cur)) return;
    f32x4 acc[2][2][4][2];
#pragma unroll
    for (int a = 0; a < 2; ++a)
#pragma unroll
        for (int b = 0; b < 2; ++b)
#pragma unroll
            for (int m = 0; m < 4; ++m)
#pragma unroll
                for (int n = 0; n < 2; ++n) acc[a][b][m][n] = (f32x4){0.f, 0.f, 0.f, 0.f};
    bf16x8 At[4][2], B0[2][2], B1[2][2];
    const char* cA = (const char*)g.A + (size_t)cur.pm * tstep; const char* cB = (const char*)g.Bt + (size_t)cur.pn * tstep;
    S.a_ready(cur);
    PG8_STAGE(PG8_SB(0, 0), cB, voffB); PG8_STAGE(PG8_SA(0, 0), cA, voffA); PG8_STAGE(PG8_SB(0, 1), cB + hstep, voffB); PG8_STAGE(PG8_SA(0, 1), cA + hstep, voffA);
    if (wr == 1) PG8_BAR;
    PG8_WAIT_V(4); PG8_BAR;
    PG8_STAGE(PG8_SB(1, 0), cB + kstep, voffB); PG8_STAGE(PG8_SA(1, 0), cA + kstep, voffA); PG8_STAGE(PG8_SB(1, 1), cB + hstep + kstep, voffB);
    PG8_WAIT_V(6); PG8_BAR;
    for (;;) {
        const bool has_next = S.next(ui + 1, nxt);
        const char* nA = has_next ? (const char*)g.A + (size_t)nxt.pm * tstep : cA; const char* nB = has_next ? (const char*)g.Bt + (size_t)nxt.pn * tstep : cB;
        for (int t = 0; t < nt; t += 2) {
            const bool last = (t == nt - 2);
            const char* a1 = cA + (size_t)(t + 1) * kstep;
            const char* a2 = last ? nA : cA + (size_t)(t + 2) * kstep; const char* b2 = last ? nB : cB + (size_t)(t + 2) * kstep;
            const char* a3 = a2 + kstep; const char* b3 = b2 + kstep;
            if (last && has_next) S.a_ready(nxt);
            PG8_LDB(B0, 0, 0); PG8_SCHED; PG8_LDA(At, 0, 0); PG8_STAGE(PG8_SA(1, 1), a1 + hstep, voffA);
            PG8_WAIT_L(8); PG8_BAR; PG8_WAIT_L(0); PG8_MMA(0, 0, At, B0); PG8_BAR; PG8_SCHED;
            PG8_LDB(B1, 0, 1); PG8_STAGE(PG8_SB(0, 0), b2, voffB);
            PG8_BAR; PG8_WAIT_L(0); PG8_MMA(0, 1, At, B1); PG8_BAR;
            PG8_LDA(At, 0, 1); PG8_STAGE(PG8_SA(0, 0), a2, voffA);
            PG8_BAR; PG8_WAIT_L(0); PG8_MMA(1, 0, At, B0); PG8_BAR; PG8_SCHED;
            PG8_STAGE(PG8_SB(0, 1), b2 + hstep, voffB);
            PG8_WAIT_V(6); PG8_BAR; PG8_MMA(1, 1, At, B1); PG8_BAR;
            PG8_LDB(B0, 1, 0); PG8_SCHED; PG8_LDA(At, 1, 0); PG8_STAGE(PG8_SA(0, 1), a2 + hstep, voffA);
            PG8_WAIT_L(8); PG8_BAR; PG8_WAIT_L(0); PG8_MMA(0, 0, At, B0); PG8_BAR; PG8_SCHED;
            PG8_LDB(B1, 1, 1); PG8_STAGE(PG8_SB(1, 0), b3, voffB);
            PG8_BAR; PG8_WAIT_L(0); PG8_MMA(0, 1, At, B1); PG8_BAR;
            PG8_LDA(At, 1, 1); PG8_STAGE(PG8_SA(1, 0), a3, voffA);
            PG8_BAR; PG8_WAIT_L(0); PG8_MMA(1, 0, At, B0); PG8_BAR; PG8_SCHED;
            PG8_STAGE(PG8_SB(1, 1), b3 + hstep, voffB);
            PG8_WAIT_V(6); PG8_BAR; PG8_MMA(1, 1, At, B1); PG8_BAR;
        }
        if constexpr (!Epi::AFTER_DRAIN) { E(acc, cur, wr, wc, fr, fq); S.done(cur); }
        if (!has_next) break;
#pragma unroll
        for (int a = 0; a < 2; ++a)
#pragma unroll
            for (int b = 0; b < 2; ++b)
#pragma unroll
                for (int m = 0; m < 4; ++m)
#pragma unroll
                    for (int n = 0; n < 2; ++n) acc[a][b][m][n] = (f32x4){0.f, 0.f, 0.f, 0.f};
        cur = nxt; cA = nA; cB = nB; ++ui;
    }
    PG8_WAIT_V(0);
    if (wr == 0) PG8_BAR;
    PG8_BAR;
    if constexpr (Epi::AFTER_DRAIN) { E.fused(acc, cur, wr, wc, fr, fq, lds, wid, lane); S.done(cur); }
#undef PG8_SA
#undef PG8_SB
#undef PG8_STAGE
#undef PG8_LDA
#undef PG8_LDB
#undef PG8_MMA
#undef PG8_WAIT_V
#undef PG8_WAIT_L
#undef PG8_BAR
#undef PG8_SCHED
}
}
using namespace pg8;
#define LAS PG8_LAS
constexpr int M_TOK = 32768, T_SEQ = 4096, DM = 1024, ZLD = 3584, NRW = 1856, DFF = 2816, KLORA = 384;
constexpr float NEPS = 1e-6f;
constexpr size_t MiB = 1u << 20;
constexpr size_t WS_W1T = 0, WS_W2T = 7 * MiB, WS_W3T = 9 * MiB, WS_W4T = 11 * MiB, WS_W5T = 22 * MiB, WS_W6T = 27 * MiB + MiB / 2, WS_W7T = 28 * MiB;
constexpr size_t WS_PB = 30 * MiB, WS_RINV = 46 * MiB, WS_SS = 47 * MiB, WS_BAR = 47 * MiB + MiB / 2;
constexpr size_t WS_XN = 48 * MiB, WS_GNL = 48 * MiB, WS_GG = 80 * MiB, WS_HN = 48 * MiB;
constexpr size_t WS_Z = 112 * MiB, WS_KK = 112 * MiB, WS_NB = 144 * MiB, WS_DF = 176 * MiB, WS_DB = 208 * MiB, WS_G = 240 * MiB, WS_YMIX = 272 * MiB;
constexpr size_t WS_H1 = 112 * MiB, WS_ACT = 240 * MiB, WS_E = 416 * MiB;
constexpr size_t WS_RKV = 336 * MiB, WS_GQKV = 432 * MiB, WS_Y = 336 * MiB;
constexpr size_t WS_END = 496 * MiB;

struct Params { const float* in[30]; float* out; unsigned char* ws; };

__device__ __forceinline__ unsigned pk2(float lo, float hi) { unsigned r; asm("v_cvt_pk_bf16_f32 %0, %1, %2" : "=v"(r) : "v"(lo), "v"(hi)); return r; }
__device__ __forceinline__ float bflo(unsigned w) { return __uint_as_float(w << 16); }
__device__ __forceinline__ float bfhi(unsigned w) { return __uint_as_float(w & 0xffff0000u); }
__device__ __forceinline__ void unpack8(const u32x4 w, float (&f)[8]) { f[0] = bflo(w.x); f[1] = bfhi(w.x); f[2] = bflo(w.y); f[3] = bfhi(w.y); f[4] = bflo(w.z); f[5] = bfhi(w.z); f[6] = bflo(w.w); f[7] = bfhi(w.w); }
__device__ __forceinline__ u32x4 pack8(const float (&f)[8]) { u32x4 o; o.x = pk2(f[0], f[1]); o.y = pk2(f[2], f[3]); o.z = pk2(f[4], f[5]); o.w = pk2(f[6], f[7]); return o; }
__device__ __forceinline__ void unpack4(const u32x2 w, float (&f)[4]) { f[0] = bflo(w.x); f[1] = bfhi(w.x); f[2] = bflo(w.y); f[3] = bfhi(w.y); }
__device__ __forceinline__ float wave_sum(float v) {
#pragma unroll
    for (int o = 1; o < 64; o <<= 1) v += __shfl_xor(v, o);
    return v;
}
__device__ __forceinline__ float sigmoidf_(float x) { return __builtin_amdgcn_rcpf(1.0f + __expf(-x)); }
__device__ __forceinline__ float siluf_(float x) { return x * __builtin_amdgcn_rcpf(1.0f + __expf(-x)); }
__device__ __forceinline__ float tanhf_(float x) { return 1.0f - 2.0f * __builtin_amdgcn_rcpf(__expf(2.0f * x) + 1.0f); }

struct EpiBf16Plain {
    static constexpr bool PERM = true, AFTER_DRAIN = false;
    bf16_t* O; int ldc;
    __device__ __forceinline__ void operator()(const f32x4 (&acc)[2][2][4][2], const Unit& u, int wr, int wc, int fr, int fq) const {
        const int row0 = u.pm * BM + wr * 64 + fr, col0 = u.pn * BM + wc * 32 + 8 * fq;
#pragma unroll
        for (int ai = 0; ai < 2; ++ai)
#pragma unroll
            for (int m = 0; m < 4; ++m) { bf16_t* rowp = O + (size_t)(row0 + ai * HALF + m * 16) * ldc + col0;
#pragma unroll
                for (int bj = 0; bj < 2; ++bj) { const f32x4 v0 = acc[ai][bj][m][0], v1 = acc[ai][bj][m][1]; u32x4 w; w.x = pk2(v0[0], v0[1]); w.y = pk2(v0[2], v0[3]); w.z = pk2(v1[0], v1[1]); w.w = pk2(v1[2], v1[3]);
                    __builtin_nontemporal_store(w, (u32x4*)(rowp + bj * HALF)); } }
    }
};
struct EpiBf16SS {
    static constexpr bool PERM = true, AFTER_DRAIN = false;
    bf16_t* O; int ldc; float* ss;
    __device__ __forceinline__ void operator()(const f32x4 (&acc)[2][2][4][2], const Unit& u, int wr, int wc, int fr, int fq) const {
        const int row0 = u.pm * BM + wr * 64 + fr, col0 = u.pn * BM + wc * 32 + 8 * fq;
#pragma unroll
        for (int ai = 0; ai < 2; ++ai)
#pragma unroll
            for (int m = 0; m < 4; ++m) { const int row = row0 + ai * HALF + m * 16; bf16_t* rowp = O + (size_t)row * ldc + col0; float s = 0.f;
#pragma unroll
                for (int bj = 0; bj < 2; ++bj) { const f32x4 v0 = acc[ai][bj][m][0], v1 = acc[ai][bj][m][1]; u32x4 w; w.x = pk2(v0[0], v0[1]); w.y = pk2(v0[2], v0[3]); w.z = pk2(v1[0], v1[1]); w.w = pk2(v1[2], v1[3]);
                    __builtin_nontemporal_store(w, (u32x4*)(rowp + bj * HALF)); s += ((v0[0] * v0[0] + v0[1] * v0[1]) + (v0[2] * v0[2] + v0[3] * v0[3])) + ((v1[0] * v1[0] + v1[1] * v1[1]) + (v1[2] * v1[2] + v1[3] * v1[3])); }
                { auto r16 = __builtin_amdgcn_permlane16_swap(__float_as_uint(s), __float_as_uint(s), false, false); s = __uint_as_float(r16[0]) + __uint_as_float(r16[1]);
                  auto r32 = __builtin_amdgcn_permlane32_swap(__float_as_uint(s), __float_as_uint(s), false, false); s = __uint_as_float(r32[0]) + __uint_as_float(r32[1]); }
                if (fq == 0) atomicAdd(ss + row, s); }
    }
};
struct EpiSwiGLU {
    static constexpr bool PERM = true, AFTER_DRAIN = false;
    bf16_t* O;
    __device__ __forceinline__ void operator()(const f32x4 (&acc)[2][2][4][2], const Unit& u, int wr, int wc, int fr, int fq) const {
        const int row0 = u.pm * BM + wr * 64 + fr, col0 = u.pn * 128 + wc * 32 + 8 * fq;
#pragma unroll
        for (int ai = 0; ai < 2; ++ai)
#pragma unroll
            for (int m = 0; m < 4; ++m) { bf16_t* rowp = O + (size_t)(row0 + ai * HALF + m * 16) * DFF + col0; float o[8];
#pragma unroll
                for (int n = 0; n < 2; ++n) { const f32x4 g = acc[ai][0][m][n], up = acc[ai][1][m][n];
#pragma unroll
                    for (int j = 0; j < 4; ++j) o[4 * n + j] = siluf_(g[j]) * up[j]; }
                u32x4 w; w.x = pk2(o[0], o[1]); w.y = pk2(o[2], o[3]); w.z = pk2(o[4], o[5]); w.w = pk2(o[6], o[7]); *(u32x4*)rowp = w; }
    }
};
struct EpiLoraW {
    static constexpr bool PERM = true, AFTER_DRAIN = false;
    const float* w0; bf16_t *DFp, *DBp;
    __device__ __forceinline__ void operator()(const f32x4 (&acc)[2][2][4][2], const Unit& u, int wr, int wc, int fr, int fq) const {
        const int row0 = u.pm * BM + wr * 64 + fr, cb = 128 * u.pn + wc * 32 + 8 * fq;
#pragma unroll
        for (int bj = 0; bj < 2; ++bj) {
            const f32x4 w0a = *(const f32x4*)(w0 + 512 * bj + cb), w0b = *(const f32x4*)(w0 + 512 * bj + cb + 4); bf16_t* D = bj ? DBp : DFp;
#pragma unroll
            for (int ai = 0; ai < 2; ++ai)
#pragma unroll
                for (int m = 0; m < 4; ++m) { const f32x4 a0 = acc[ai][bj][m][0], a1 = acc[ai][bj][m][1]; float d[8];
#pragma unroll
                    for (int j = 0; j < 4; ++j) { d[j] = 0.60653066f * sigmoidf_(w0a[j] + a0[j]); d[4 + j] = 0.60653066f * sigmoidf_(w0b[j] + a1[j]); }
                    *(u32x4*)(D + (size_t)(row0 + ai * HALF + m * 16) * 512 + cb) = pack8(d); asm volatile("" ::: "memory"); }
        }
    }
};
struct EpiLoraAG {
    static constexpr bool PERM = true, AFTER_DRAIN = false;
    const float *a0, *k_k, *k_a; const float* rinv; bf16_t *RKV, *KK, *NB, *G;
    __device__ __forceinline__ void operator()(const f32x4 (&acc)[2][2][4][2], const Unit& u, int wr, int wc, int fr, int fq) const {
        const int row0 = u.pm * BM + wr * 64 + fr, cb = 128 * u.pn + wc * 32 + 8 * fq;
#pragma unroll
        for (int ai = 0; ai < 2; ++ai)
#pragma unroll
            for (int m = 0; m < 4; ++m) { const f32x4 g0 = acc[ai][1][m][0], g1 = acc[ai][1][m][1]; u32x4 w; w.x = pk2(g0[0], g0[1]); w.y = pk2(g0[2], g0[3]); w.z = pk2(g1[0], g1[1]); w.w = pk2(g1[2], g1[3]);
                *(u32x4*)(G + (size_t)(row0 + ai * HALF + m * 16) * 512 + cb) = w; }
        asm volatile("" ::: "memory");
#pragma unroll
        for (int ai = 0; ai < 2; ++ai)
#pragma unroll
            for (int m = 0; m < 4; ++m) { const int row = row0 + ai * HALF + m * 16; const size_t off = (size_t)row * 512 + cb; bf16_t* kp = RKV + (size_t)row * 1536 + 512 + cb;
                float ks[8], av[8], t[8]; unpack8(*(const u32x4*)kp, ks);
                { const f32x4 c0 = *(const f32x4*)(a0 + cb), c1 = *(const f32x4*)(a0 + cb + 4); const f32x4 x0 = acc[ai][0][m][0], x1 = acc[ai][0][m][1];
#pragma unroll
                  for (int j = 0; j < 4; ++j) { av[j] = sigmoidf_(c0[j] + x0[j]); av[4 + j] = sigmoidf_(c1[j] + x1[j]); } }
                { const f32x4 c0 = *(const f32x4*)(k_a + cb), c1 = *(const f32x4*)(k_a + cb + 4);
#pragma unroll
                  for (int j = 0; j < 4; ++j) { t[j] = ks[j] * (1.0f + (av[j] - 1.0f) * c0[j]); t[4 + j] = ks[4 + j] * (1.0f + (av[4 + j] - 1.0f) * c1[j]); } }
                *(u32x4*)kp = pack8(t);
                { const f32x4 c0 = *(const f32x4*)(k_k + cb), c1 = *(const f32x4*)(k_k + cb + 4); const float ri = rinv[row * 8 + (cb >> 6)];
#pragma unroll
                  for (int j = 0; j < 4; ++j) { t[j] = ks[j] * c0[j] * ri; t[4 + j] = ks[4 + j] * c1[j] * ri; } }
                *(u32x4*)(KK + off) = pack8(t);
#pragma unroll
                for (int e = 0; e < 8; ++e) t[e] = -t[e] * av[e];
                *(u32x4*)(NB + off) = pack8(t);
                asm volatile("" ::: "memory"); }
    }
};
struct EpiPleGate {
    static constexpr bool PERM = true, AFTER_DRAIN = false;
    bf16_t* C; const float* bias; const bf16_t* E; float* ss;
    __device__ __forceinline__ void operator()(const f32x4 (&acc)[2][2][4][2], const Unit& u, int wr, int wc, int fr, int fq) const {
        const int row0 = u.pm * BM + wr * 64 + fr, col0 = u.pn * BM + wc * 32 + 8 * fq;
        f32x4 bv[2][2];
#pragma unroll
        for (int bj = 0; bj < 2; ++bj)
#pragma unroll
            for (int n = 0; n < 2; ++n) bv[bj][n] = *(const f32x4*)(bias + col0 + bj * HALF + 4 * n);
#pragma unroll
        for (int ai = 0; ai < 2; ++ai)
#pragma unroll
            for (int m = 0; m < 4; ++m) { const int row = row0 + ai * HALF + m * 16; const size_t off = (size_t)row * DM + col0; float s = 0.f;
#pragma unroll
                for (int bj = 0; bj < 2; ++bj) { float e[8], o[8]; unpack8(*(const u32x4*)(E + off + bj * HALF), e);
#pragma unroll
                    for (int n = 0; n < 2; ++n) { const f32x4 v = acc[ai][bj][m][n] + bv[bj][n];
#pragma unroll
                        for (int j = 0; j < 4; ++j) { o[4 * n + j] = sigmoidf_(v[j]) * e[4 * n + j]; s += o[4 * n + j] * o[4 * n + j]; } }
                    __builtin_nontemporal_store(pack8(o), (u32x4*)(C + off + bj * HALF)); }
                { auto r16 = __builtin_amdgcn_permlane16_swap(__float_as_uint(s), __float_as_uint(s), false, false); s = __uint_as_float(r16[0]) + __uint_as_float(r16[1]);
                  auto r32 = __builtin_amdgcn_permlane32_swap(__float_as_uint(s), __float_as_uint(s), false, false); s = __uint_as_float(r32[0]) + __uint_as_float(r32[1]); }
                if (fq == 0) atomicAdd(ss + row, s); }
    }
};
#define XB_TMO      128
#define XB_XCNT(j)  (256  + 64 * (j))
#define XB_XSUB(j)  (1280 + 64 * (j))
#define XB_XGEN(j)  (2304 + 64 * (j))
#define XB_TOP      3328
#define XB_TOPGEN   3392
#define XCD_BAR_WORDS 3456
#define XB_SPIN_CAP (1u << 18)

__device__ __forceinline__ unsigned xb_ld(unsigned* p)              { return __hip_atomic_load(p, __ATOMIC_RELAXED, __HIP_MEMORY_SCOPE_AGENT); }
__device__ __forceinline__ unsigned xb_add(unsigned* p, unsigned v) { return __hip_atomic_fetch_add(p, v, __ATOMIC_RELAXED, __HIP_MEMORY_SCOPE_AGENT); }
__device__ __forceinline__ unsigned xb_xcc_id() { return (unsigned)__builtin_amdgcn_s_getreg((3 << 11) | 20) & 0xFu; }
#define XB_SPIN(cond, bar) do { unsigned _sp = 0; while (cond) { __builtin_amdgcn_s_sleep(1); \
    if ((++_sp & 255u) == 0u) { if (xb_ld(&(bar)[XB_TMO])) break; if (_sp > XB_SPIN_CAP) { atomicAdd(&(bar)[XB_TMO], 1u); break; } } } } while (0)

struct XcdBarrier {
    unsigned* bar; unsigned x;
    volatile LAS unsigned* st;
};

__device__ __forceinline__ XcdBarrier xcd_barrier_post(unsigned* bar, volatile LAS unsigned* st) {
    XcdBarrier b; b.bar = bar; b.x = xb_xcc_id(); b.st = st;
    if (threadIdx.x == 0) (void)xb_add(&bar[XB_XCNT(b.x)], 1u);
    return b;
}
__device__ __forceinline__ void xcd_barrier_complete(unsigned* bar, unsigned x, unsigned& nloc, unsigned& nx) {
    const unsigned G = gridDim.x * gridDim.y * gridDim.z;
    unsigned sum, cnt, mine, sp = 0u;
    for (;;) {
        sum = 0u; cnt = 0u; mine = 0u;
#pragma unroll
        for (unsigned j = 0; j < 16; ++j) { const unsigned c = xb_ld(&bar[XB_XCNT(j)]); sum += c; cnt += (c > 0u) ? 1u : 0u; mine = (j == x) ? c : mine; }
        if (sum == G) break;
        __builtin_amdgcn_s_sleep(1);
        if ((++sp & 255u) == 0u) { if (xb_ld(&bar[XB_TMO])) break; if (sp > XB_SPIN_CAP) { atomicAdd(&bar[XB_TMO], 1u); break; } }
    }
    nloc = mine > 0u ? mine : 1u; nx = cnt > 0u ? cnt : 1u;
}

__device__ __forceinline__ void xcd_barrier(const XcdBarrier& b) {
    asm volatile("s_waitcnt vmcnt(0)" ::: "memory");
    __syncthreads();
    if (threadIdx.x == 0) {
        unsigned* bar = b.bar;
        __builtin_amdgcn_s_waitcnt(0);
        unsigned nloc = b.st[0], nx = b.st[1];
        if (nloc == 0u) { xcd_barrier_complete(bar, b.x, nloc, nx); b.st[0] = nloc; b.st[1] = nx; }
        const unsigned old = xb_add(&bar[XB_XSUB(b.x)], 1u);
        const unsigned gen = old / nloc;
        if (old + 1u == (gen + 1u) * nloc) {
            __builtin_amdgcn_fence(__ATOMIC_RELEASE, "agent");
            asm volatile("s_waitcnt vmcnt(0)" ::: "memory");
            const unsigned og = xb_add(&bar[XB_TOP], 1u);
            const unsigned tg = og / nx;
            if (og + 1u == (tg + 1u) * nx) xb_add(&bar[XB_TOPGEN], 1u);
            else XB_SPIN(xb_ld(&bar[XB_TOPGEN]) == tg, bar);
            __builtin_amdgcn_fence(__ATOMIC_ACQUIRE, "agent");
            xb_add(&bar[XB_XGEN(b.x)], 1u);
            asm volatile("s_waitcnt vmcnt(0)" ::: "memory");
        } else {
            XB_SPIN(xb_ld(&bar[XB_XGEN(b.x)]) == gen, bar);
            __builtin_amdgcn_fence(__ATOMIC_ACQUIRE, "agent");
            asm volatile("s_waitcnt vmcnt(0)" ::: "memory");
        }
    }
    __syncthreads();
}

__device__ __forceinline__ float red8s(float x) {
    x += __int_as_float(__builtin_amdgcn_update_dpp(0, __float_as_int(x), 0xB1, 0xF, 0xF, true));
    x += __int_as_float(__builtin_amdgcn_update_dpp(0, __float_as_int(x), 0x4E, 0xF, 0xF, true));
    x += __int_as_float(__builtin_amdgcn_update_dpp(0, __float_as_int(x), 0x141, 0xF, 0xF, true));
    return x;
}
__device__ __forceinline__ float red16s(float x) { x = red8s(x); x += __int_as_float(__builtin_amdgcn_update_dpp(0, __float_as_int(x), 0x140, 0xF, 0xF, true)); return x; }
__device__ __forceinline__ void transpose_item(const float* W, int N, int col0, bf16_t* WT, int K, int drow0, int k0, LAS float* scr, int lane) {
#pragma unroll 8
    for (int i = 0; i < 32; ++i) { const int kk = 2 * i + (lane >> 5); scr[kk * 33 + (lane & 31)] = col0 >= 0 ? __builtin_nontemporal_load(W + (size_t)(k0 + kk) * N + col0 + (lane & 31)) : 0.f; }
    asm volatile("s_waitcnt lgkmcnt(0)" ::: "memory");
    const int c = lane & 7;
#pragma unroll
    for (int j = 0; j < 4; ++j) { const int n = (lane >> 3) + 8 * j; const LAS float* s = scr + (8 * c) * 33 + n;
        u32x4 o; o.x = pk2(s[0 * 33], s[1 * 33]); o.y = pk2(s[2 * 33], s[3 * 33]); o.z = pk2(s[4 * 33], s[5 * 33]); o.w = pk2(s[6 * 33], s[7 * 33]);
        *(u32x4*)(WT + (size_t)(drow0 + n) * K + k0 + 8 * c) = o; }
    asm volatile("s_waitcnt lgkmcnt(0)" ::: "memory");
}
__device__ __forceinline__ void phase0(const Params& p, LAS unsigned char* lds, int wid, int lane) {
    unsigned char* ws = p.ws;
    LAS float* scr = (LAS float*)(lds + wid * 8448);
    const int gw = blockIdx.x * 8 + wid, NGW = gridDim.x * 8;
    constexpr int I1 = 16 * 112, I3 = 16 * 32, I4 = 16 * 176, I5 = 44 * 32, I6 = 4 * 32, I7 = 16 * 32, NIT = I1 + I3 + I4 + I5 + I6 + I7;
    for (int it = gw; it < NIT; it += NGW) {
        int r = it;
        if (r < I1) { const int kb = r / 112, nb = r % 112; transpose_item(p.in[7], 3424, nb * 32 < 3424 ? nb * 32 : -1, (bf16_t*)(ws + WS_W1T), 1024, nb * 32, kb * 64, scr, lane); continue; } r -= I1;
        if (r < I3) { const int kb = r / 32, nb = r % 32; transpose_item(p.in[23], 1024, nb * 32, (bf16_t*)(ws + WS_W3T), 1024, nb * 32, kb * 64, scr, lane); continue; } r -= I3;
        if (r < I4) { const int kb = r / 176, nb = r % 176, n0 = nb * 32, u = n0 >> 8, bj = (n0 >> 7) & 1, cc = n0 & 127;
            transpose_item(bj ? p.in[25] : p.in[24], DFF, 128 * u + cc, (bf16_t*)(ws + WS_W4T), 1024, n0, kb * 64, scr, lane); continue; } r -= I4;
        if (r < I5) { const int kb = r / 32, nb = r % 32; transpose_item(p.in[26], 1024, nb * 32, (bf16_t*)(ws + WS_W5T), DFF, nb * 32, kb * 64, scr, lane); continue; } r -= I5;
        if (r < I6) { const int kb = r / 32, nb = r % 32; transpose_item(p.in[27], 1024, nb * 32, (bf16_t*)(ws + WS_W6T), 256, nb * 32, kb * 64, scr, lane); continue; } r -= I6;
        { const int kb = r / 32, nb = r % 32; transpose_item(p.in[28], 1024, nb * 32, (bf16_t*)(ws + WS_W7T), 1024, nb * 32, kb * 64, scr, lane); }
    }
    const int gt = blockIdx.x * 512 + threadIdx.x, GT = gridDim.x * 512;
    {
        bf16_t* W2 = (bf16_t*)(ws + WS_W2T); const float* wup = p.in[10]; const float* aup = p.in[12]; const float* gup = p.in[13];
        for (int idx = gt; idx < 2048 * KLORA; idx += GT) { const int n = idx / KLORA, kk = idx % KLORA, u = n >> 8, bj = (n >> 7) & 1, col = 128 * (u & 3) + (n & 127); float v = 0.f;
            if (u < 4) { if (bj == 0) { if (kk < 64) v = wup[(size_t)kk * 512 + col]; } else { if (kk >= 64 && kk < 128) v = wup[(size_t)(64 + kk - 64) * 512 + col]; } }
            else { if (bj == 0) { if (kk >= 128 && kk < 192) v = aup[(size_t)(kk - 128) * 512 + col]; } else { if (kk >= 192 && kk < 320) v = gup[(size_t)(kk - 192) * 512 + col]; } }
            W2[idx] = (bf16_t)(pk2(v, 0.f) & 0xffffu); }
    }
    {
        const f32x4* src = (const f32x4*)p.in[1]; u32x2* dst = (u32x2*)(ws + WS_PB);
        for (int i = gt; i < M_TOK * 256 / 4; i += GT) { const f32x4 v = __builtin_nontemporal_load(src + i); u32x2 w; w.x = pk2(v[0], v[1]); w.y = pk2(v[2], v[3]); dst[i] = w; }
        float* ss = (float*)(ws + WS_SS);
        for (int i = gt; i < 3 * M_TOK; i += GT) ss[i] = 0.f;
    }
    {
        const float* nw = p.in[2]; f32x4 wv[4];
#pragma unroll
        for (int j = 0; j < 4; ++j) wv[j] = *(const f32x4*)(nw + 4 * lane + 256 * j);
        bf16_t* XN = (bf16_t*)(ws + WS_XN);
        for (int t = gw; t < M_TOK; t += NGW) { const float* xr = p.in[0] + (size_t)t * DM; f32x4 v[4]; float s = 0.f;
#pragma unroll
            for (int j = 0; j < 4; ++j) { v[j] = __builtin_nontemporal_load((const f32x4*)(xr + 4 * lane + 256 * j)); s += (v[j][0] * v[j][0] + v[j][1] * v[j][1]) + (v[j][2] * v[j][2] + v[j][3] * v[j][3]); }
            const float rs = rsqrtf(wave_sum(s) * (1.0f / DM) + NEPS);
#pragma unroll
            for (int j = 0; j < 4; ++j) { const f32x4 o = v[j] * rs * wv[j]; u32x2 w; w.x = pk2(o[0], o[1]); w.y = pk2(o[2], o[3]); *(u32x2*)(XN + (size_t)t * DM + 4 * lane + 256 * j) = w; } }
    }
}
template <int CH> __device__ __forceinline__ void p2_rwkv_chunk(const Params& p, int t0, int lane) {
    unsigned char* ws = p.ws;
    const int chunk = lane + 64 * CH, c = chunk * 8;
    bf16_t* RKV = (bf16_t*)(ws + WS_RKV); bf16_t* AP = (bf16_t*)p.out; float* RINV = (float*)(ws + WS_RINV);
    if (CH == 3 && chunk >= 232) {
        if (chunk < 240) { const u32x4 zero = {0u, 0u, 0u, 0u};
#pragma unroll 4
            for (int i = 0; i < 16; ++i) *(u32x4*)(AP + (size_t)(t0 + i) * KLORA + 320 + (chunk - 232) * 8) = zero; }
        return; }
    const bf16_t* zc = (const bf16_t*)(ws + WS_Z) + (size_t)t0 * ZLD + c;
    float mu[8], kq[8];
    { const f32x4 m0 = *(const f32x4*)(p.in[8] + c), m1 = *(const f32x4*)(p.in[8] + c + 4);
#pragma unroll
      for (int i = 0; i < 4; ++i) { mu[i] = m0[i]; mu[4 + i] = m1[i]; } }
    if (CH == 1) { const f32x4 q0 = *(const f32x4*)(p.in[14] + c - 512), q1 = *(const f32x4*)(p.in[14] + c - 512 + 4);
#pragma unroll
        for (int i = 0; i < 4; ++i) { kq[i] = q0[i]; kq[4 + i] = q1[i]; } }
    float P[8], C[8], N[8];
    if ((t0 & (T_SEQ - 1)) != 0) unpack8(__builtin_nontemporal_load((const u32x4*)(zc - ZLD)), P); else {
#pragma unroll
        for (int i = 0; i < 8; ++i) P[i] = 0.f; }
    unpack8(__builtin_nontemporal_load((const u32x4*)(zc)), C);
    u32x4 raw = __builtin_nontemporal_load((const u32x4*)(zc + ZLD));
#pragma unroll 2
    for (int i = 0; i < 16; ++i) {
        const int t = t0 + i; const bool hasn = (t & (T_SEQ - 1)) != T_SEQ - 1;
        if (hasn) unpack8(raw, N); else {
#pragma unroll
            for (int q = 0; q < 8; ++q) N[q] = 0.f; }
        if (i < 15 && ((t + 1) & (T_SEQ - 1)) != T_SEQ - 1) raw = __builtin_nontemporal_load((const u32x4*)(zc + (size_t)(i + 2) * ZLD));
        float zs[8];
#pragma unroll
        for (int q = 0; q < 8; ++q) zs[q] = C[q] + mu[q] * (0.5f * (P[q] + N[q]) - C[q]);
        if (CH < 3) {
            *(u32x4*)(RKV + (size_t)t * 1536 + c) = pack8(zs);
            if (CH == 1) { float s2 = 0.f;
#pragma unroll
                for (int q = 0; q < 8; ++q) { const float v = zs[q] * kq[q]; s2 += v * v; }
                s2 = red8s(s2);
                if ((lane & 7) == 0) RINV[t * 8 + (lane >> 3)] = rsqrtf(fmaxf(s2, 1e-24f)); }
        } else {
            const int cc = c - 1536; float o[8];
#pragma unroll
            for (int q = 0; q < 8; ++q) o[q] = cc < 128 ? tanhf_(zs[q]) : (cc < 192 ? zs[q] : sigmoidf_(zs[q]));
            *(u32x4*)(AP + (size_t)t * KLORA + cc) = pack8(o);
        }
#pragma unroll
        for (int q = 0; q < 8; ++q) { P[q] = C[q]; C[q] = N[q]; }
    }
}
template <int CH> __device__ __forceinline__ void p2_gla_chunk(const Params& p, int t0, int lane) {
    unsigned char* ws = p.ws;
    const int c = (lane + 64 * CH) * 8; const float sc = c < 256 ? 0.125f : 1.0f;
    bf16_t* GQKV = (bf16_t*)(ws + WS_GQKV);
    const bf16_t* zc = (const bf16_t*)(ws + WS_Z) + (size_t)t0 * ZLD + NRW + c;
    float w0[8], w1[8], w2[8];
#pragma unroll
    for (int h = 0; h < 2; ++h) { const f32x4 a = *(const f32x4*)(p.in[19] + c + 4 * h), b = *(const f32x4*)(p.in[19] + 1024 + c + 4 * h), d = *(const f32x4*)(p.in[19] + 2048 + c + 4 * h);
#pragma unroll
        for (int i = 0; i < 4; ++i) { w0[4 * h + i] = a[i]; w1[4 * h + i] = b[i]; w2[4 * h + i] = d[i]; } }
    float P[8], C[8], N[8];
    if ((t0 & (T_SEQ - 1)) != 0) unpack8(__builtin_nontemporal_load((const u32x4*)(zc - ZLD)), P); else {
#pragma unroll
        for (int i = 0; i < 8; ++i) P[i] = 0.f; }
    unpack8(__builtin_nontemporal_load((const u32x4*)(zc)), C);
    u32x4 raw = __builtin_nontemporal_load((const u32x4*)(zc + ZLD));
#pragma unroll 2
    for (int i = 0; i < 16; ++i) {
        const int t = t0 + i; const bool hasn = (t & (T_SEQ - 1)) != T_SEQ - 1;
        if (hasn) unpack8(raw, N); else {
#pragma unroll
            for (int q = 0; q < 8; ++q) N[q] = 0.f; }
        if (i < 15 && ((t + 1) & (T_SEQ - 1)) != T_SEQ - 1) raw = __builtin_nontemporal_load((const u32x4*)(zc + (size_t)(i + 2) * ZLD));
        float o[8];
#pragma unroll
        for (int q = 0; q < 8; ++q) { const float y = w0[q] * P[q] + w1[q] * C[q] + w2[q] * N[q]; o[q] = siluf_(y) * sc; }
        *(u32x4*)(GQKV + (size_t)t * 1024 + c) = pack8(o);
#pragma unroll
        for (int q = 0; q < 8; ++q) { P[q] = C[q]; C[q] = N[q]; }
    }
}
__device__ __forceinline__ void p2_gate(const Params& p, const LAS float* aup, int t0, int lane) {
    unsigned char* ws = p.ws; bf16_t* GNL = (bf16_t*)(ws + WS_GNL); bf16_t* GG = (bf16_t*)(ws + WS_GG); const float* ab = p.in[21];
    const f32x4 ab0 = *(const f32x4*)(ab + 4 * lane), ab1 = *(const f32x4*)(ab + 256 + 4 * lane);
#pragma unroll 2
    for (int i = 0; i < 16; ++i) {
        const int t = t0 + i; const bf16_t* zg = (const bf16_t*)(ws + WS_Z) + (size_t)t * ZLD + NRW;
        *(u32x4*)(GG + (size_t)t * 512 + lane * 8) = __builtin_nontemporal_load((const u32x4*)(zg + 1024 + lane * 8));
        const unsigned short araw = zg[1536 + (lane & 31)]; const int alo = (int)((unsigned)araw << 16);
        f32x4 acc0 = ab0, acc1 = ab1;
#pragma unroll
        for (int r = 0; r < 16; ++r) { const float a0 = __int_as_float(__builtin_amdgcn_readlane(alo, r)), a1 = __int_as_float(__builtin_amdgcn_readlane(alo, 16 + r));
            acc0 += a0 * *(const LAS f32x4*)(aup + r * 256 + 4 * lane); acc1 += a1 * *(const LAS f32x4*)(aup + (16 + r) * 256 + 4 * lane); }
        float n0[4], n1[4];
#pragma unroll
        for (int j = 0; j < 4; ++j) { const float y0 = -acc0[j], y1 = -acc1[j];
            n0[j] = (fmaxf(y0, 0.f) + __logf(1.0f + __expf(-fabsf(y0)))) * 0.0625f; n1[j] = (fmaxf(y1, 0.f) + __logf(1.0f + __expf(-fabsf(y1)))) * 0.0625f; }
        u32x2 w; w.x = pk2(n0[0], n0[1]); w.y = pk2(n0[2], n0[3]); *(u32x2*)(GNL + (size_t)t * 512 + 4 * lane) = w;
        w.x = pk2(n1[0], n1[1]); w.y = pk2(n1[2], n1[3]); *(u32x2*)(GNL + (size_t)t * 512 + 256 + 4 * lane) = w;
    }
}
__device__ __forceinline__ void phase2(const Params& p, LAS unsigned char* lds, int wid, int lane) {
    const float* aupg = p.in[20];
    LAS float* aup = (LAS float*)lds;
    for (int i = threadIdx.x; i < 2 * 16 * 256; i += 512) aup[i] = aupg[i];
    __syncthreads();
    const int gw = blockIdx.x * 8 + wid, NGW = gridDim.x * 8;
    for (int grp = gw; grp < M_TOK / 16; grp += NGW) {
        const int t0 = grp * 16;
        p2_rwkv_chunk<0>(p, t0, lane); p2_rwkv_chunk<1>(p, t0, lane); p2_rwkv_chunk<2>(p, t0, lane); p2_rwkv_chunk<3>(p, t0, lane);
        p2_gla_chunk<0>(p, t0, lane); p2_gla_chunk<1>(p, t0, lane);
        p2_gate(p, aup, t0, lane);
    }
}
constexpr int SC_CH = 16;
constexpr int SB_XA = 0, SB_XB = 4608, SB_XBT = 9216, SB_VT = 14336, SB_WE = 17408, SC_BUF = 17664;
constexpr int SW_GR = 0, SW_HT = 1024, SW_GYT = 2560, SW_TIT = 4096, SW_SIZE = 5632, SC_IMG = 4 * SC_BUF;
typedef float f32x16 __attribute__((ext_vector_type(16)));
typedef __bf16 bf16x2_t __attribute__((ext_vector_type(2)));
__device__ __forceinline__ unsigned cvt2(float a, float b) { f32x2 v = {a, b}; bf16x2_t r = __builtin_convertvector(v, bf16x2_t); return __builtin_bit_cast(unsigned, r); }
__device__ __forceinline__ bf16x8 pack8r(float a, float b, float c, float d, float e, float f, float g, float hh) { u32x4 p; p.x = cvt2(a, b); p.y = cvt2(c, d); p.z = cvt2(e, f); p.w = cvt2(g, hh); return __builtin_bit_cast(bf16x8, p); }
#define MFMA32(a, b, c) __builtin_amdgcn_mfma_f32_32x32x16_bf16((a), (b), (c), 0, 0, 0)
struct ScanSrc { const bf16_t* v[6]; int ld[6]; bf16_t* out; int rev; int tokbase; };
struct ScanLd { u32x2 rd, rk, rr, rv, rkk, rnb; };
template <bool RWKV> __device__ __forceinline__ void scan_load_issue(ScanLd& L, const ScanSrc& S, int chunk, int lt) {
    const int lw = lt >> 6, lane = lt & 63, sl = lane >> 2, col = 16 * lw + 4 * (lane & 3), s = chunk * SC_CH + sl; const size_t tok = (size_t)(S.tokbase + (S.rev ? T_SEQ - 1 - s : s));
    L.rd = *(const u32x2*)(S.v[0] + tok * S.ld[0] + col); L.rk = *(const u32x2*)(S.v[1] + tok * S.ld[1] + col); L.rr = *(const u32x2*)(S.v[4] + tok * S.ld[4] + col); L.rv = *(const u32x2*)(S.v[5] + tok * S.ld[5] + col);
    L.rkk = L.rk; L.rnb = L.rk;
    if (RWKV) { L.rkk = *(const u32x2*)(S.v[2] + tok * S.ld[2] + col); L.rnb = *(const u32x2*)(S.v[3] + tok * S.ld[3] + col); }
}
template <bool RWKV> __device__ __forceinline__ void scan_load_finish(LAS unsigned char* buf, const ScanLd& L, int lt) {
    const int lw = lt >> 6, lane = lt & 63, sl = lane >> 2, col = 16 * lw + 4 * (lane & 3);
    float d[4], c[4], k[4], r[4], v[4], kk[4], nb[4];
    unpack4(L.rd, d); unpack4(L.rk, k); unpack4(L.rr, r); unpack4(L.rv, v); unpack4(L.rkk, kk); unpack4(L.rnb, nb);
#pragma unroll
    for (int i = 0; i < 4; ++i) c[i] = d[i];
#pragma unroll
    for (int dl = 4; dl < 64; dl <<= 1)
#pragma unroll
        for (int i = 0; i < 4; ++i) { const float t = __shfl_up(c[i], dl); c[i] += (lane >= dl) ? t : 0.f; }
    float o1[4], o2[4], o3[4], o4[4]; f32x4 we;
#pragma unroll
    for (int i = 0; i < 4; ++i) { const float W = __expf(-c[i]), iW = __expf(c[i]), Wp = __expf(d[i] - c[i]); o1[i] = RWKV ? kk[i] * Wp : 0.f; o2[i] = RWKV ? nb[i] * iW : 0.f; o3[i] = k[i] * iW; o4[i] = r[i] * W; we[i] = W; }
    u32x2 w;
    w.x = cvt2(o1[0], o1[1]); w.y = cvt2(o1[2], o1[3]); *(LAS u32x2*)(buf + SB_XA + sl * 144 + col * 2) = w;
    w.x = cvt2(o4[0], o4[1]); w.y = cvt2(o4[2], o4[3]); *(LAS u32x2*)(buf + SB_XA + (16 + sl) * 144 + col * 2) = w;
    w.x = cvt2(o2[0], o2[1]); w.y = cvt2(o2[2], o2[3]); *(LAS u32x2*)(buf + SB_XB + sl * 144 + col * 2) = w;
    w.x = cvt2(o3[0], o3[1]); w.y = cvt2(o3[2], o3[3]); *(LAS u32x2*)(buf + SB_XB + (16 + sl) * 144 + col * 2) = w;
#pragma unroll
    for (int i = 0; i < 4; ++i) {
        *(LAS unsigned short*)(buf + SB_XBT + (col + i) * 80 + sl * 2) = (unsigned short)(cvt2(o2[i], 0.f) & 0xffffu);
        *(LAS unsigned short*)(buf + SB_XBT + (col + i) * 80 + (16 + sl) * 2) = (unsigned short)(cvt2(o3[i], 0.f) & 0xffffu);
        *(LAS unsigned short*)(buf + SB_VT + (col + i) * 48 + sl * 2) = (unsigned short)(cvt2(v[i], 0.f) & 0xffffu); }
    if (sl == SC_CH - 1) *(LAS f32x4*)(buf + SB_WE + col * 4) = we;
}
template <bool RWKV> __device__ __forceinline__ void scan_prep_m1(const LAS unsigned char* buf, LAS unsigned char* img, int lane) {
    const int r = lane & 31, h = lane >> 5;
    f32x16 gh;
#pragma unroll
    for (int i = 0; i < 16; ++i) gh[i] = 0.f;
#pragma unroll
    for (int kb = 0; kb < 4; ++kb) { const bf16x8 a = *(const LAS bf16x8*)(buf + SB_XB + r * 144 + (16 * kb + 8 * h) * 2), b = *(const LAS bf16x8*)(buf + SB_XA + r * 144 + (16 * kb + 8 * h) * 2); gh = MFMA32(a, b, gh); }
    const int lim = r < 16 ? r : r - 15;
#pragma unroll
    for (int g = 0; g < 2; ++g) { const int t0 = 8 * g + 4 * h; float x[4], y[4];
#pragma unroll
        for (int q = 0; q < 4; ++q) { x[q] = (t0 + q < lim) ? gh[4 * g + q] : 0.f; y[q] = (t0 + q < lim) ? gh[8 + 4 * g + q] : 0.f; }
        if (RWKV && r < 16) {
#pragma unroll
            for (int q = 0; q < 4; ++q) *(LAS float*)(img + SW_GR + ((t0 + q) * 16 + r) * 4) = x[q]; }
        u32x2 wv; wv.x = r >= 16 ? cvt2(x[0], x[1]) : 0u; wv.y = r >= 16 ? cvt2(x[2], x[3]) : 0u; *(LAS u32x2*)(img + SW_GYT + r * 48 + t0 * 2) = wv;
        wv.x = cvt2(y[0], y[1]); wv.y = cvt2(y[2], y[3]); *(LAS u32x2*)(img + SW_HT + r * 48 + t0 * 2) = wv; }
}
template <bool RWKV> __device__ __forceinline__ void scan_prep_inv(LAS unsigned char* img, int lane) {
    const int r = lane & 31;
    if (RWKV) {
        const int sc = lane & 15; float X[16];
#pragma unroll
        for (int t = 15; t >= 0; --t) { float acc = (t == sc) ? 1.f : 0.f;
#pragma unroll
            for (int m4 = (t + 1) / 4; m4 < 4; ++m4) { const f32x4 gv = *(const LAS f32x4*)(img + SW_GR + (t * 16 + 4 * m4) * 4);
#pragma unroll
                for (int q = 0; q < 4; ++q) if (4 * m4 + q > t) acc = fmaf(gv[q], X[4 * m4 + q], acc); }
            X[t] = acc; }
        if (lane < 32) { u32x4 p0, p1; const bool z = r >= 16;
            p0.x = z ? 0u : cvt2(X[0], X[1]); p0.y = z ? 0u : cvt2(X[2], X[3]); p0.z = z ? 0u : cvt2(X[4], X[5]); p0.w = z ? 0u : cvt2(X[6], X[7]);
            p1.x = z ? 0u : cvt2(X[8], X[9]); p1.y = z ? 0u : cvt2(X[10], X[11]); p1.z = z ? 0u : cvt2(X[12], X[13]); p1.w = z ? 0u : cvt2(X[14], X[15]);
            *(LAS u32x4*)(img + SW_TIT + r * 48) = p0; *(LAS u32x4*)(img + SW_TIT + r * 48 + 16) = p1; }
    }
}
__device__ __forceinline__ bf16x8 lds_aperm(const LAS unsigned char* rowp, int h) {
    const u32x2 a0 = *(const LAS u32x2*)(rowp + 8 * h), a1 = *(const LAS u32x2*)(rowp + 16 + 8 * h); u32x4 aa; aa.x = a0.x; aa.y = a0.y; aa.z = a1.x; aa.w = a1.y; return __builtin_bit_cast(bf16x8, aa);
}
template <bool RWKV> __device__ __forceinline__ void scan_chunk(const LAS unsigned char* buf, const LAS unsigned char* img, f32x16 (&T)[2], const ScanSrc& S, int chunk, int w, int lane) {
    const int r = lane & 31, h = lane >> 5;
    f32x16 zero;
#pragma unroll
    for (int i = 0; i < 16; ++i) zero[i] = 0.f;
    const bf16x8 vb = *(const LAS bf16x8*)(buf + SB_VT + (32 * w + r) * 48 + 16 * h);
    f32x16 ry = zero, ry2 = zero;
#pragma unroll
    for (int kb = 0; kb < 2; ++kb) {
        const bf16x8 b0 = pack8r(T[0][8 * kb], T[0][8 * kb + 1], T[0][8 * kb + 2], T[0][8 * kb + 3], T[0][8 * kb + 4], T[0][8 * kb + 5], T[0][8 * kb + 6], T[0][8 * kb + 7]);
        const bf16x8 b1 = pack8r(T[1][8 * kb], T[1][8 * kb + 1], T[1][8 * kb + 2], T[1][8 * kb + 3], T[1][8 * kb + 4], T[1][8 * kb + 5], T[1][8 * kb + 6], T[1][8 * kb + 7]);
        ry = MFMA32(lds_aperm(buf + SB_XA + r * 144 + (16 * kb) * 2, h), b0, ry);
        ry2 = MFMA32(lds_aperm(buf + SB_XA + r * 144 + (32 + 16 * kb) * 2, h), b1, ry2); }
    { const bf16x8 a = *(const LAS bf16x8*)(img + SW_HT + r * 48 + 16 * h); ry = MFMA32(a, vb, ry); }
#pragma unroll
    for (int i = 0; i < 16; ++i) ry[i] += ry2[i];
    bf16x8 ub;
    if (RWKV) {
        const bf16x8 rb = pack8r(ry[0], ry[1], ry[2], ry[3], ry[4], ry[5], ry[6], ry[7]);
        const f32x16 ua = MFMA32(lds_aperm(img + SW_TIT + r * 48, h), rb, zero);
        ub = pack8r(ua[0], ua[1], ua[2], ua[3], ua[4], ua[5], ua[6], ua[7]);
        ry = MFMA32(lds_aperm(img + SW_GYT + r * 48, h), ub, ry);
    }
    {
        const int s0 = chunk * SC_CH; const long tok0 = (long)S.tokbase + (S.rev ? T_SEQ - 1 - s0 : s0), dstep = S.rev ? -512 : 512;
        bf16_t* op = S.out + tok0 * 512 + 32 * w + r;
#pragma unroll
        for (int q = 8; q < 16; ++q) { const int s = (q & 3) + 8 * ((q >> 2) - 2) + 4 * h; op[s * dstep] = (bf16_t)(cvt2(ry[q], 0.f) & 0xffffu); }
    }
#pragma unroll
    for (int jt = 0; jt < 2; ++jt) {
        if (RWKV) T[jt] = MFMA32(lds_aperm(buf + SB_XBT + (32 * jt + r) * 80, h), ub, T[jt]);
        { const bf16x8 a = *(const LAS bf16x8*)(buf + SB_XBT + (32 * jt + r) * 80 + 32 + 16 * h); T[jt] = MFMA32(a, vb, T[jt]); }
#pragma unroll
        for (int g = 0; g < 4; ++g) { const f32x4 we = *(const LAS f32x4*)(buf + SB_WE + (32 * jt + 8 * g + 4 * h) * 4);
#pragma unroll
            for (int q = 0; q < 4; ++q) T[jt][4 * g + q] *= we[q]; }
    }
}
template <bool RWKV> __device__ __forceinline__ void scan_item(LAS unsigned char* lds, const ScanSrc& S, int wid, int lane) {
    f32x16 T[2];
#pragma unroll
    for (int a = 0; a < 2; ++a)
#pragma unroll
        for (int i = 0; i < 16; ++i) T[a][i] = 0.f;
    const bool is_ld = (wid == 4) | (wid == 5) | (wid == 3) | (wid == 7); const bool is_prep = wid == 2;
    const int lt = (wid == 4 ? 0 : wid == 5 ? 64 : wid == 3 ? 128 : 192) + lane;
    ScanLd L;
    constexpr int NCH = T_SEQ / SC_CH;
#define SC_BAR() do { asm volatile("s_waitcnt lgkmcnt(0)" ::: "memory"); __builtin_amdgcn_s_barrier(); asm volatile("" ::: "memory"); } while (0)
    const bool is_inv = wid == 6;
    if (is_ld) { scan_load_issue<RWKV>(L, S, 0, lt); scan_load_finish<RWKV>(lds, L, lt); scan_load_issue<RWKV>(L, S, 1, lt); scan_load_finish<RWKV>(lds + SC_BUF, L, lt);
                 scan_load_issue<RWKV>(L, S, 2, lt); scan_load_finish<RWKV>(lds + 2 * SC_BUF, L, lt); scan_load_issue<RWKV>(L, S, 3, lt); }
    __syncthreads();
    if (is_prep) { scan_prep_m1<RWKV>(lds, lds + SC_IMG, lane); scan_prep_m1<RWKV>(lds + SC_BUF, lds + SC_IMG + SW_SIZE, lane); }
    SC_BAR();
    if (is_inv) scan_prep_inv<RWKV>(lds + SC_IMG, lane);
    SC_BAR();
    int b0 = 0, i0 = 0;
    for (int c = 0; c < NCH; ++c) {
        const int i1 = i0 == 2 ? 0 : i0 + 1, i2 = i1 == 2 ? 0 : i1 + 1;
        if (is_ld) {
            if (c + 3 < NCH) scan_load_finish<RWKV>(lds + ((b0 + 3) & 3) * SC_BUF, L, lt);
            if (c + 4 < NCH) scan_load_issue<RWKV>(L, S, c + 4, lt); }
        else if (is_prep) { if (c + 2 < NCH) scan_prep_m1<RWKV>(lds + ((b0 + 2) & 3) * SC_BUF, lds + SC_IMG + i2 * SW_SIZE, lane); }
        else if (is_inv) { if (c + 1 < NCH) scan_prep_inv<RWKV>(lds + SC_IMG + i1 * SW_SIZE, lane); }
        else if (wid < 2) scan_chunk<RWKV>(lds + b0 * SC_BUF, lds + SC_IMG + i0 * SW_SIZE, T, S, c, wid, lane);
        SC_BAR();
        b0 = (b0 + 1) & 3; i0 = i1;
    }
#undef SC_BAR
}
__device__ __forceinline__ void phase3(const Params& p, LAS unsigned char* lds, int wid, int lane) {
    unsigned char* ws = p.ws; bf16_t* yo = (bf16_t*)p.out;
    const bf16_t* RKV = (const bf16_t*)(ws + WS_RKV); const bf16_t* KK = (const bf16_t*)(ws + WS_KK); const bf16_t* NB = (const bf16_t*)(ws + WS_NB);
    const bf16_t* DFp = (const bf16_t*)(ws + WS_DF); const bf16_t* DBp = (const bf16_t*)(ws + WS_DB);
    const bf16_t* GQKV = (const bf16_t*)(ws + WS_GQKV); const bf16_t* GNL = (const bf16_t*)(ws + WS_GNL);
    for (int item = blockIdx.x; item < 256; item += gridDim.x) {
        ScanSrc S;
        if (item < 128) {
            const int dir = item & 1, h = (item >> 1) & 7, b = item >> 4;
            S.v[0] = (dir ? DBp : DFp) + h * 64; S.ld[0] = 512; S.v[1] = RKV + 512 + h * 64; S.ld[1] = 1536; S.v[2] = KK + h * 64; S.ld[2] = 512; S.v[3] = NB + h * 64; S.ld[3] = 512;
            S.v[4] = RKV + h * 64; S.ld[4] = 1536; S.v[5] = RKV + 1024 + h * 64; S.ld[5] = 1536;
            S.out = yo + (size_t)dir * M_TOK * 512 + h * 64; S.rev = dir; S.tokbase = b * T_SEQ;
            scan_item<true>(lds, S, wid, lane);
        } else {
            const int i2 = item - 128, half = i2 & 1, dir = (i2 >> 1) & 1, h = (i2 >> 2) & 3, b = i2 >> 4;
            S.v[0] = GNL + dir * 256 + h * 64; S.ld[0] = 512; S.v[1] = GQKV + 256 + h * 64; S.ld[1] = 1024; S.v[2] = S.v[1]; S.ld[2] = 0; S.v[3] = S.v[1]; S.ld[3] = 0;
            S.v[4] = GQKV + h * 64; S.ld[4] = 1024; S.v[5] = GQKV + 512 + h * 128 + half * 64; S.ld[5] = 1024;
            S.out = yo + (size_t)(2 + dir) * M_TOK * 512 + h * 128 + half * 64; S.rev = dir; S.tokbase = b * T_SEQ;
            scan_item<false>(lds, S, wid, lane);
        }
        __syncthreads();
    }
}
__device__ __forceinline__ void phase4(const Params& p, int wid, int lane) {
    unsigned char* ws = p.ws; const bf16_t* yo = (const bf16_t*)p.out;
    const bf16_t* RKV = (const bf16_t*)(ws + WS_RKV); const bf16_t* G = (const bf16_t*)(ws + WS_G); const bf16_t* GG = (const bf16_t*)(ws + WS_GG); bf16_t* YM = (bf16_t*)(ws + WS_YMIX);
    const int c = lane * 8;
    float rk[8], lw[8], lb[8], gn[8];
#pragma unroll
    for (int i = 0; i < 8; ++i) { rk[i] = p.in[16][c + i]; lw[i] = p.in[17][c + i]; lb[i] = p.in[18][c + i]; gn[i] = p.in[22][(c + i) & 127]; }
    const int gw = blockIdx.x * 8 + wid, NGW = gridDim.x * 8;
    for (int t = gw; t < M_TOK; t += NGW) {
        const size_t o5 = (size_t)t * 512 + c;
        {
            float yf[8], yb[8], y[8], r[8], k[8], v[8], g[8];
            unpack8(__builtin_nontemporal_load((const u32x4*)(yo + o5)), yf); unpack8(__builtin_nontemporal_load((const u32x4*)(yo + (size_t)M_TOK * 512 + o5)), yb);
            unpack8(__builtin_nontemporal_load((const u32x4*)(RKV + (size_t)t * 1536 + c)), r); unpack8(__builtin_nontemporal_load((const u32x4*)(RKV + (size_t)t * 1536 + 512 + c)), k); unpack8(__builtin_nontemporal_load((const u32x4*)(RKV + (size_t)t * 1536 + 1024 + c)), v);
            unpack8(__builtin_nontemporal_load((const u32x4*)(G + o5)), g);
            float s = 0.f, bsum = 0.f;
#pragma unroll
            for (int i = 0; i < 8; ++i) { y[i] = yf[i] + yb[i]; s += y[i]; bsum += r[i] * k[i] * rk[i]; }
            s = red8s(s); bsum = red8s(bsum);
            const float mean = s * (1.0f / 64.0f); float q = 0.f;
#pragma unroll
            for (int i = 0; i < 8; ++i) { y[i] -= mean; q += y[i] * y[i]; }
            q = red8s(q);
            const float rstd = rsqrtf(q * (1.0f / 64.0f) + 64e-5f); float o[8];
#pragma unroll
            for (int i = 0; i < 8; ++i) o[i] = (y[i] * rstd * lw[i] + lb[i] + bsum * v[i]) * g[i];
            *(u32x4*)(YM + (size_t)t * DM + c) = pack8(o);
        }
        {
            float of[8], ob[8], o[8], g[8];
            unpack8(__builtin_nontemporal_load((const u32x4*)(yo + (size_t)2 * M_TOK * 512 + o5)), of); unpack8(__builtin_nontemporal_load((const u32x4*)(yo + (size_t)3 * M_TOK * 512 + o5)), ob); unpack8(__builtin_nontemporal_load((const u32x4*)(GG + o5)), g);
            float q = 0.f;
#pragma unroll
            for (int i = 0; i < 8; ++i) { o[i] = of[i] + ob[i]; q += o[i] * o[i]; }
            q = red16s(q);
            const float rs = rsqrtf(q * (1.0f / 128.0f) + NEPS); float r[8];
#pragma unroll
            for (int i = 0; i < 8; ++i) r[i] = o[i] * rs * gn[i] * siluf_(g[i]);
            *(u32x4*)(YM + (size_t)t * DM + 512 + c) = pack8(r);
        }
    }
}
template <int MODE> __device__ __forceinline__ void phase_row(const void* basev, const bf16_t* add, const float* ss, const float* wpost, const float* wpre, void* outv, bf16_t* HB, int wid, int lane) {
    float wp[2][8], wq[2][8];
#pragma unroll
    for (int j = 0; j < 2; ++j)
#pragma unroll
        for (int i = 0; i < 8; ++i) { wp[j][i] = wpost[8 * lane + 512 * j + i]; wq[j][i] = MODE == 0 ? wpre[8 * lane + 512 * j + i] : 1.f; }
    const int gw = blockIdx.x * 8 + wid, NGW = gridDim.x * 8;
    for (int t = gw; t < M_TOK; t += NGW) {
        const size_t off = (size_t)t * DM + 8 * lane; const float rs = rsqrtf(ss[t] * (1.0f / DM) + NEPS); float h[2][8]; float s = 0.f;
#pragma unroll
        for (int j = 0; j < 2; ++j) { float b[8], a[8];
            if (MODE == 0) { const f32x4 b0 = __builtin_nontemporal_load((const f32x4*)((const float*)basev + off + 512 * j)), b1 = __builtin_nontemporal_load((const f32x4*)((const float*)basev + off + 512 * j + 4));
#pragma unroll
                for (int i = 0; i < 4; ++i) { b[i] = b0[i]; b[4 + i] = b1[i]; } }
            else unpack8(__builtin_nontemporal_load((const u32x4*)((const bf16_t*)basev + off + 512 * j)), b);
            unpack8(__builtin_nontemporal_load((const u32x4*)(add + off + 512 * j)), a);
#pragma unroll
            for (int i = 0; i < 8; ++i) { h[j][i] = b[i] + a[i] * rs * wp[j][i]; s += h[j][i] * h[j][i]; } }
        if (MODE == 2) {
#pragma unroll
            for (int j = 0; j < 2; ++j) { float* o = (float*)outv + off + 512 * j; __builtin_nontemporal_store((f32x4){h[j][0], h[j][1], h[j][2], h[j][3]}, (f32x4*)o); __builtin_nontemporal_store((f32x4){h[j][4], h[j][5], h[j][6], h[j][7]}, (f32x4*)(o + 4)); }
        } else {
#pragma unroll
            for (int j = 0; j < 2; ++j) *(u32x4*)((bf16_t*)outv + off + 512 * j) = pack8(h[j]);
        }
        if (MODE == 0) { const float r2 = rsqrtf(wave_sum(s) * (1.0f / DM) + NEPS);
#pragma unroll
            for (int j = 0; j < 2; ++j) { float o[8];
#pragma unroll
                for (int i = 0; i < 8; ++i) o[i] = h[j][i] * r2 * wq[j][i];
                *(u32x4*)(HB + off + 512 * j) = pack8(o); } }
    }
}
__global__ void __launch_bounds__(512, 2) hymba_fwd(Params p) {
    extern __shared__ __attribute__((aligned(16))) unsigned char lds_raw[];
    LAS unsigned char* lds = (LAS unsigned char*)lds_raw;
    cg::grid_group grid = cg::this_grid();
    volatile LAS unsigned* stw = (volatile LAS unsigned*)(lds + 131072);
    if (threadIdx.x == 0) { stw[0] = 0u; stw[1] = 0u; }
    __syncthreads();
    const XcdBarrier xbar = xcd_barrier_post((unsigned*)(p.ws + WS_BAR), stw);
    int wid, lane;
#define GETWL() do { int t_ = threadIdx.x; asm volatile("" : "+v"(t_)); wid = __builtin_amdgcn_readfirstlane(t_ >> 6); lane = t_ & 63; } while (0)
    unsigned char* ws = p.ws; const int G = gridDim.x, c = blockIdx.x;
    float* SS = (float*)(ws + WS_SS);
    GETWL();
    phase0(p, lds, wid, lane);
    if (p.ws == nullptr) grid.sync();
    xcd_barrier(xbar);
    {
        Gemm g{(const bf16_t*)(ws + WS_XN), (const bf16_t*)(ws + WS_W1T), M_TOK, ZLD, DM}; StaticOrder S; S.init(M_TOK, ZLD, G, c);
        EpiBf16Plain E{(bf16_t*)(ws + WS_Z), ZLD}; gemm_phase<EpiBf16Plain, StaticOrder>(lds, g, S, E); }
    xcd_barrier(xbar);
    GETWL();
    phase2(p, lds, wid, lane);
    xcd_barrier(xbar);
    {
        Gemm g{(const bf16_t*)p.out, (const bf16_t*)(ws + WS_W2T), M_TOK, 1024, KLORA}; StaticOrder S; S.init(M_TOK, 1024, G, c);
        EpiLoraW E{p.in[9], (bf16_t*)(ws + WS_DF), (bf16_t*)(ws + WS_DB)}; gemm_phase<EpiLoraW, StaticOrder>(lds, g, S, E);
        Gemm g2{(const bf16_t*)p.out, (const bf16_t*)(ws + WS_W2T) + (size_t)1024 * KLORA, M_TOK, 1024, KLORA};
        EpiLoraAG E2{p.in[11], p.in[14], p.in[15], (const float*)(ws + WS_RINV), (bf16_t*)(ws + WS_RKV), (bf16_t*)(ws + WS_KK), (bf16_t*)(ws + WS_NB), (bf16_t*)(ws + WS_G)};
        gemm_phase<EpiLoraAG, StaticOrder>(lds, g2, S, E2); }
    xcd_barrier(xbar);
    GETWL();
    phase3(p, lds, wid, lane);
    xcd_barrier(xbar);
    GETWL();
    phase4(p, wid, lane);
    xcd_barrier(xbar);
    {
        Gemm g{(const bf16_t*)(ws + WS_YMIX), (const bf16_t*)(ws + WS_W3T), M_TOK, DM, DM}; StaticOrder S; S.init(M_TOK, DM, G, c);
        EpiBf16SS E{(bf16_t*)(ws + WS_Y), DM, SS}; gemm_phase<EpiBf16SS, StaticOrder>(lds, g, S, E); }
    xcd_barrier(xbar);
    GETWL();
    phase_row<0>(p.in[0], (const bf16_t*)(ws + WS_Y), SS, p.in[3], p.in[4], ws + WS_H1, (bf16_t*)(ws + WS_HN), wid, lane);
    xcd_barrier(xbar);
    {
        Gemm g{(const bf16_t*)(ws + WS_HN), (const bf16_t*)(ws + WS_W4T), M_TOK, 2 * DFF, DM}; StaticOrder S; S.init(M_TOK, 2 * DFF, G, c);
        EpiSwiGLU E{(bf16_t*)(ws + WS_ACT)}; gemm_phase<EpiSwiGLU, StaticOrder>(lds, g, S, E); }
    xcd_barrier(xbar);
    {
        Gemm g{(const bf16_t*)(ws + WS_ACT), (const bf16_t*)(ws + WS_W5T), M_TOK, DM, DFF}; StaticOrder S; S.init(M_TOK, DM, G, c);
        EpiBf16SS E{(bf16_t*)p.out, DM, SS + M_TOK}; gemm_phase<EpiBf16SS, StaticOrder>(lds, g, S, E);
        Gemm g2{(const bf16_t*)(ws + WS_PB), (const bf16_t*)(ws + WS_W6T), M_TOK, DM, 256}; StaticOrder S2; S2.init(M_TOK, DM, G, c);
        EpiBf16Plain E2{(bf16_t*)(ws + WS_E), DM}; gemm_phase<EpiBf16Plain, StaticOrder>(lds, g2, S2, E2); }
    xcd_barrier(xbar);
    GETWL();
    phase_row<1>(ws + WS_H1, (const bf16_t*)p.out, SS + M_TOK, p.in[5], nullptr, ws + WS_HN, nullptr, wid, lane);
    xcd_barrier(xbar);
    {
        Gemm g{(const bf16_t*)(ws + WS_HN), (const bf16_t*)(ws + WS_W7T), M_TOK, DM, DM}; StaticOrder S; S.init(M_TOK, DM, G, c);
        EpiPleGate E{(bf16_t*)(ws + WS_Y), p.in[29], (const bf16_t*)(ws + WS_E), SS + 2 * M_TOK}; gemm_phase<EpiPleGate, StaticOrder>(lds, g, S, E); }
    xcd_barrier(xbar);
    GETWL();
    phase_row<2>(ws + WS_HN, (const bf16_t*)(ws + WS_Y), SS + 2 * M_TOK, p.in[6], nullptr, p.out, nullptr, wid, lane);
}
extern "C" void kernel_launch(void* const* d_in, const int* in_sizes, int n_in, void* d_out, int out_size, void* d_ws, size_t ws_size, hipStream_t stream) {
    constexpr size_t kLds = 131072 + 64;
    static int grid_blocks = 0;
    if (!grid_blocks) {
        int dev = 0, cus = 0, per_cu = 0;
        if (n_in != 30 || out_size != M_TOK * DM || ws_size < WS_END) { fprintf(stderr, "kernel_launch: unexpected shapes (n_in %d, out %d, ws %zu, need %zu)\n", n_in, out_size, ws_size, (size_t)WS_END); grid_blocks = -1; return; }
        (void)hipGetDevice(&dev);
        (void)hipDeviceGetAttribute(&cus, hipDeviceAttributeMultiprocessorCount, dev);
        (void)hipFuncSetAttribute((const void*)hymba_fwd, hipFuncAttributeMaxDynamicSharedMemorySize, (int)kLds);
        (void)hipOccupancyMaxActiveBlocksPerMultiprocessor(&per_cu, (const void*)hymba_fwd, 512, kLds);
        if (per_cu < 1) { fprintf(stderr, "kernel_launch: occupancy query reports %d blocks/CU\n", per_cu); grid_blocks = -1; return; }
        grid_blocks = cus;
    }
    if (grid_blocks < 0) return;
    (void)hipMemsetAsync((unsigned char*)d_ws + WS_BAR, 0, XCD_BAR_WORDS * 4, stream);
    Params p{};
    for (int i = 0; i < 30; ++i) p.in[i] = (const float*)d_in[i];
    p.out = (float*)d_out; p.ws = (unsigned char*)d_ws;
    void* args[] = {&p};
    hipError_t e = hipLaunchCooperativeKernel((const void*)hymba_fwd, dim3(grid_blocks), dim3(512), args, kLds, stream);
    if (e != hipSuccess) fprintf(stderr, "cooperative launch failed: %s (grid %d)\n", hipGetErrorString(e), grid_blocks);
}
```

```cpp
#include <hip/hip_runtime.h>
#include <hip/hip_cooperative_groups.h>
#include <cstdio>
namespace cg = cooperative_groups;
namespace pg8 {
#define PG8_LAS __attribute__((address_space(3)))
typedef unsigned short bf16_t;
typedef short bf16x8 __attribute__((ext_vector_type(8)));
typedef float f32x4 __attribute__((ext_vector_type(4)));
typedef float f32x2 __attribute__((ext_vector_type(2)));
typedef unsigned u32x4 __attribute__((ext_vector_type(4)));
typedef unsigned u32x2 __attribute__((ext_vector_type(2)));
constexpr int BM = 256, BK = 64, HALF = 128, HTB = HALF * BK * 2, STAGE_BYTES = 8 * HTB, NXCD = 8, WGM = 8;
__host__ __device__ __forceinline__ int lds_byte(int r, int c) { const int st = (r >> 4) * 2 + (c >> 5), rr = r & 15, cc = c & 31, ob = rr * 64 + cc * 2; return st * 1024 + (ob ^ (((ob >> 9) & 1) << 5)); }
__host__ __device__ __forceinline__ void stage_rc(int b, int& R, int& C) { const int st = b / 1024, sb = b % 1024, swz = sb ^ (((sb >> 9) & 1) << 5); R = (st >> 1) * 16 + swz / 64; C = (st & 1) * 32 + (swz % 64) / 2; }
__host__ __device__ __forceinline__ int perm32(int rho) { const int n = rho >> 4, i = rho & 15; return 8 * (i >> 2) + 4 * n + (i & 3); }
struct Unit { int pm, pn; };
struct Gemm { const bf16_t* A; const bf16_t* Bt; int M, N, K; };
struct StaticOrder {
    int nM, nN, nwg, G, c;
    __host__ __device__ void init(int M, int N, int G_, int c_) { nM = M / BM; nN = N / BM; nwg = nM * nN; G = G_; c = c_; }
    __host__ __device__ bool next(int i, Unit& u) const {
        const long L = (long)i * G + c; if (L >= nwg) return false;
        int wgid = (int)L; { const int q = nwg / NXCD, r = nwg % NXCD, xcd = wgid % NXCD, off = wgid / NXCD; wgid = (xcd < r ? xcd * (q + 1) : r * (q + 1) + (xcd - r) * q) + off; }
        const int nig = WGM * nN, gid = wgid / nig, fm = gid * WGM, gsz = (nM - fm) < WGM ? (nM - fm) : WGM;
        u.pm = fm + ((wgid % nig) % gsz); u.pn = (wgid % nig) / gsz; return true;
    }
    __device__ __forceinline__ void a_ready(const Unit&) const {}
    __device__ __forceinline__ void done(const Unit&) const {}
};
__device__ __forceinline__ unsigned cvt_pk_bf16(float lo, float hi) { unsigned r; asm volatile("v_cvt_pk_bf16_f32 %0, %1, %2" : "=v"(r) : "v"(lo), "v"(hi)); return r; }
template <class Epi, class Sched>
__device__ __forceinline__ void gemm_phase(PG8_LAS unsigned char* lds, const Gemm g, const Sched& S, const Epi& E) {
    int tid_ = threadIdx.x; asm volatile("" : "+v"(tid_));
    const int tid = tid_, wid = __builtin_amdgcn_readfirstlane(tid >> 6), lane = tid & 63, wr = wid >> 2, wc = wid & 3, fr = lane & 15, fq = lane >> 4;
    const int K = g.K, nt = K / BK;
    unsigned voffA[2], voffB[2];
#pragma unroll
    for (int i = 0; i < 2; ++i) { int R, C; stage_rc(tid * 16 + i * 8192, R, C); const int Rb = Epi::PERM ? ((R & ~31) + perm32(R & 31)) : R;
        voffA[i] = (unsigned)(R * K + C) * 2u; voffB[i] = (unsigned)(Rb * K + C) * 2u; }
    const size_t kstep = (size_t)(BK * 2);
    const size_t hstep = (size_t)HALF * K * 2;
    const size_t tstep = 2 * hstep;
    const unsigned ldsw = (unsigned)wid * 1024u;
    const int aoff = lds_byte(wr * 64 + fr, fq * 8), boff = lds_byte(wc * 32 + fr, fq * 8);
#define PG8_SA(b, h) (((b) * 2 + (h)) * HTB)
#define PG8_SB(b, h) ((4 + (b) * 2 + (h)) * HTB)
#define PG8_STAGE(bufoff, gbase, voff) do { _Pragma("unroll") for (int _i = 0; _i < 2; ++_i) \
        __builtin_amdgcn_global_load_lds((const unsigned*)((const char*)(gbase) + (voff)[_i]), (PG8_LAS unsigned*)(lds + (bufoff) + ldsw + _i * 8192), 16, 0, 0); } while (0)
#define PG8_LDA(dst, b, h) do { _Pragma("unroll") for (int m = 0; m < 4; ++m) _Pragma("unroll") for (int k = 0; k < 2; ++k) dst[m][k] = *(const PG8_LAS bf16x8*)(lds + PG8_SA(b, h) + aoff + m * 2048 + k * 1024); } while (0)
#define PG8_LDB(dst, b, h) do { _Pragma("unroll") for (int n = 0; n < 2; ++n) _Pragma("unroll") for (int k = 0; k < 2; ++k) dst[n][k] = *(const PG8_LAS bf16x8*)(lds + PG8_SB(b, h) + boff + n * 2048 + k * 1024); } while (0)
#define PG8_MMA(ai, bj, At, Bt) do { __builtin_amdgcn_s_setprio(1); _Pragma("unroll") for (int m = 0; m < 4; ++m) _Pragma("unroll") for (int n = 0; n < 2; ++n) _Pragma("unroll") for (int k = 0; k < 2; ++k) \
        acc[ai][bj][m][n] = __builtin_amdgcn_mfma_f32_16x16x32_bf16(Bt[n][k], At[m][k], acc[ai][bj][m][n], 0, 0, 0); __builtin_amdgcn_s_setprio(0); } while (0)
#define PG8_WAIT_V(n) asm volatile("s_waitcnt vmcnt(" #n ")" ::: "memory")
#define PG8_WAIT_L(n) asm volatile("s_waitcnt lgkmcnt(" #n ")" ::: "memory")
#define PG8_BAR __builtin_amdgcn_s_barrier()
#define PG8_SCHED __builtin_amdgcn_sched_barrier(0)
    Unit cur, nxt; int ui = 0;
    if (!S.next(0, cur)) return;
    f32x4 acc[2][2][4][2];
#pragma unroll
    for (int a = 0; a < 2; ++a)
#pragma unroll
        for (int b = 0; b < 2; ++b)
#pragma unroll
            for (int m = 0; m < 4; ++m)
#pragma unroll
                for (int n = 0; n < 2; ++n) acc[a][b][m][n] = (f32x4){0.f, 0.f, 0.f, 0.f};
    bf16x8 At[4][2], B0[2][2], B1[2][2];
    const char* cA = (const char*)g.A + (size_t)cur.pm * tstep; const char* cB = (const char*)g.Bt + (size_t)cur.pn * tstep;
    S.a_ready(cur);
    PG8_STAGE(PG8_SB(0, 0), cB, voffB); PG8_STAGE(PG8_SA(0, 0), cA, voffA); PG8_STAGE(PG8_SB(0, 1), cB + hstep, voffB); PG8_STAGE(PG8_SA(0, 1), cA + hstep, voffA);
    if (wr == 1) PG8_BAR;
    PG8_WAIT_V(4); PG8_BAR;
    PG8_STAGE(PG8_SB(1, 0), cB + kstep, voffB); PG8_STAGE(PG8_SA(1, 0), cA + kstep, voffA); PG8_STAGE(PG8_SB(1, 1), cB + hstep + kstep, voffB);
    PG8_WAIT_V(6); PG8_BAR;
    for (;;) {
        const bool has_next = S.next(ui + 1, nxt);
        const char* nA = has_next ? (const char*)g.A + (size_t)nxt.pm * tstep : cA; const char* nB = has_next ? (const char*)g.Bt + (size_t)nxt.pn * tstep : cB;
        for (int t = 0; t < nt; t += 2) {
            const bool last = (t == nt - 2);
            const char* a1 = cA + (size_t)(t + 1) * kstep;
            const char* a2 = last ? nA : cA + (size_t)(t + 2) * kstep; const char* b2 = last ? nB : cB + (size_t)(t + 2) * kstep;
            const char* a3 = a2 + kstep; const char* b3 = b2 + kstep;
            if (last && has_next) S.a_ready(nxt);
            PG8_LDB(B0, 0, 0); PG8_SCHED; PG8_LDA(At, 0, 0); PG8_STAGE(PG8_SA(1, 1), a1 + hstep, voffA);
            PG8_WAIT_L(8); PG8_BAR; PG8_WAIT_L(0); PG8_MMA(0, 0, At, B0); PG8_BAR; PG8_SCHED;
            PG8_LDB(B1, 0, 1); PG8_STAGE(PG8_SB(0, 0), b2, voffB);
            PG8_BAR; PG8_WAIT_L(0); PG8_MMA(0, 1, At, B1); PG8_BAR;
            PG8_LDA(At, 0, 1); PG8_STAGE(PG8_SA(0, 0), a2, voffA);
            PG8_BAR; PG8_WAIT_L(0); PG8_MMA(1, 0, At, B0); PG8_BAR; PG8_SCHED;
            PG8_STAGE(PG8_SB(0, 1), b2 + hstep, voffB);
            PG8_WAIT_V(6); PG8_BAR; PG8_MMA(1, 1, At, B1); PG8_BAR;
            PG8_LDB(B0, 1, 0); PG8_SCHED; PG8_LDA(At, 1, 0); PG8_STAGE(PG8_SA(0, 1), a2 + hstep, voffA);
            PG8_WAIT_L(8); PG8_BAR; PG8_WAIT_L(0); PG8_MMA(0, 0, At, B0); PG8_BAR; PG8_SCHED;
            PG8_LDB(B1, 1, 1); PG8_STAGE(PG8_SB(1, 0), b3, voffB);
            PG8_BAR; PG8_WAIT_L(0); PG8_MMA(0, 1, At, B1); PG8_BAR;
            PG8_LDA(At, 1, 1); PG8_STAGE(PG8_SA(1, 0), a3, voffA);
            PG8_BAR; PG8_WAIT_L(0); PG8_MMA(1, 0, At, B0); PG8_BAR; PG8_SCHED;
            PG8_STAGE(PG8_SB(1, 1), b3 + hstep, voffB);
            PG8_WAIT_V(6); PG8_BAR; PG8_MMA(1, 1, At, B1); PG8_BAR;
        }
        if constexpr (!Epi::AFTER_DRAIN) { E(acc, cur, wr, wc, fr, fq); S.done(cur); }
        if (!has_next) break;
#pragma unroll
        for (int a = 0; a < 2; ++a)
#pragma unroll
            for (int b = 0; b < 2; ++b)
#pragma unroll
                for (int m = 0; m < 4; ++m)
#pragma unroll
                    for (int n = 0; n < 2; ++n) acc[a][b][m][n] = (f32x4){0.f, 0.f, 0.f, 0.f};
        cur = nxt; cA = nA; cB = nB; ++ui;
    }
    PG8_WAIT_V(0);
    if (wr == 0) PG8_BAR;
    PG8_BAR;
    if constexpr (Epi::AFTER_DRAIN) { E.fused(acc, cur, wr, wc, fr, fq, lds, wid, lane); S.done(cur); }
#undef PG8_SA
#undef PG8_SB
#undef PG8_STAGE
#undef PG8_LDA
#undef PG8_LDB
#undef PG8_MMA
#undef PG8_WAIT_V
#undef PG8_WAIT_L
#undef PG8_BAR
#undef PG8_SCHED
}
}
using namespace pg8;
#define LAS PG8_LAS
constexpr int M_TOK = 32768, T_SEQ = 4096, DM = 1024, ZLD = 3584, NRW = 1856, DFF = 2816, KLORA = 384;
constexpr float NEPS = 1e-6f;
constexpr size_t MiB = 1u << 20;
constexpr size_t WS_W1T = 0, WS_W2T = 7 * MiB, WS_W3T = 9 * MiB, WS_W4T = 11 * MiB, WS_W5T = 22 * MiB, WS_W6T = 27 * MiB + MiB / 2, WS_W7T = 28 * MiB;
constexpr size_t WS_PB = 30 * MiB, WS_RINV = 46 * MiB, WS_SS = 47 * MiB, WS_BAR = 47 * MiB + MiB / 2;
constexpr size_t WS_XN = 48 * MiB, WS_GNL = 48 * MiB, WS_GG = 80 * MiB, WS_HN = 48 * MiB;
constexpr size_t WS_Z = 112 * MiB, WS_KK = 112 * MiB, WS_NB = 144 * MiB, WS_DF = 176 * MiB, WS_DB = 208 * MiB, WS_G = 240 * MiB, WS_YMIX = 272 * MiB;
constexpr size_t WS_H1 = 112 * MiB, WS_ACT = 240 * MiB, WS_E = 416 * MiB;
constexpr size_t WS_RKV = 336 * MiB, WS_GQKV = 432 * MiB, WS_Y = 336 * MiB;
constexpr size_t WS_END = 496 * MiB;

struct Params { const float* in[30]; float* out; unsigned char* ws; };

__device__ __forceinline__ unsigned pk2(float lo, float hi) { unsigned r; asm("v_cvt_pk_bf16_f32 %0, %1, %2" : "=v"(r) : "v"(lo), "v"(hi)); return r; }
__device__ __forceinline__ float bflo(unsigned w) { return __uint_as_float(w << 16); }
__device__ __forceinline__ float bfhi(unsigned w) { return __uint_as_float(w & 0xffff0000u); }
__device__ __forceinline__ void unpack8(const u32x4 w, float (&f)[8]) { f[0] = bflo(w.x); f[1] = bfhi(w.x); f[2] = bflo(w.y); f[3] = bfhi(w.y); f[4] = bflo(w.z); f[5] = bfhi(w.z); f[6] = bflo(w.w); f[7] = bfhi(w.w); }
__device__ __forceinline__ u32x4 pack8(const float (&f)[8]) { u32x4 o; o.x = pk2(f[0], f[1]); o.y = pk2(f[2], f[3]); o.z = pk2(f[4], f[5]); o.w = pk2(f[6], f[7]); return o; }
__device__ __forceinline__ void unpack4(const u32x2 w, float (&f)[4]) { f[0] = bflo(w.x); f[1] = bfhi(w.x); f[2] = bflo(w.y); f[3] = bfhi(w.y); }
__device__ __forceinline__ float wave_sum(float v) {
#pragma unroll
    for (int o = 1; o < 64; o <<= 1) v += __shfl_xor(v, o);
    return v;
}
__device__ __forceinline__ float sigmoidf_(float x) { return __builtin_amdgcn_rcpf(1.0f + __expf(-x)); }
__device__ __forceinline__ float siluf_(float x) { return x * __builtin_amdgcn_rcpf(1.0f + __expf(-x)); }
__device__ __forceinline__ float tanhf_(float x) { return 1.0f - 2.0f * __builtin_amdgcn_rcpf(__expf(2.0f * x) + 1.0f); }

struct EpiBf16Plain {
    static constexpr bool PERM = true, AFTER_DRAIN = false;
    bf16_t* O; int ldc;
    __device__ __forceinline__ void operator()(const f32x4 (&acc)[2][2][4][2], const Unit& u, int wr, int wc, int fr, int fq) const {
        const int row0 = u.pm * BM + wr * 64 + fr, col0 = u.pn * BM + wc * 32 + 8 * fq;
#pragma unroll
        for (int ai = 0; ai < 2; ++ai)
#pragma unroll
            for (int m = 0; m < 4; ++m) { bf16_t* rowp = O + (size_t)(row0 + ai * HALF + m * 16) * ldc + col0;
#pragma unroll
                for (int bj = 0; bj < 2; ++bj) { const f32x4 v0 = acc[ai][bj][m][0], v1 = acc[ai][bj][m][1]; u32x4 w; w.x = pk2(v0[0], v0[1]); w.y = pk2(v0[2], v0[3]); w.z = pk2(v1[0], v1[1]); w.w = pk2(v1[2], v1[3]);
                    __builtin_nontemporal_store(w, (u32x4*)(rowp + bj * HALF)); } }
    }
};
struct EpiBf16SS {
    static constexpr bool PERM = true, AFTER_DRAIN = false;
    bf16_t* O; int ldc; float* ss;
    __device__ __forceinline__ void operator()(const f32x4 (&acc)[2][2][4][2], const Unit& u, int wr, int wc, int fr, int fq) const {
        const int row0 = u.pm * BM + wr * 64 + fr, col0 = u.pn * BM + wc * 32 + 8 * fq;
#pragma unroll
        for (int ai = 0; ai < 2; ++ai)
#pragma unroll
            for (int m = 0; m < 4; ++m) { const int row = row0 + ai * HALF + m * 16; bf16_t* rowp = O + (size_t)row * ldc + col0; float s = 0.f;
#pragma unroll
                for (int bj = 0; bj < 2; ++bj) { const f32x4 v0 = acc[ai][bj][m][0], v1 = acc[ai][bj][m][1]; u32x4 w; w.x = pk2(v0[0], v0[1]); w.y = pk2(v0[2], v0[3]); w.z = pk2(v1[0], v1[1]); w.w = pk2(v1[2], v1[3]);
                    __builtin_nontemporal_store(w, (u32x4*)(rowp + bj * HALF)); s += ((v0[0] * v0[0] + v0[1] * v0[1]) + (v0[2] * v0[2] + v0[3] * v0[3])) + ((v1[0] * v1[0] + v1[1] * v1[1]) + (v1[2] * v1[2] + v1[3] * v1[3])); }
                { auto r16 = __builtin_amdgcn_permlane16_swap(__float_as_uint(s), __float_as_uint(s), false, false); s = __uint_as_float(r16[0]) + __uint_as_float(r16[1]);
                  auto r32 = __builtin_amdgcn_permlane32_swap(__float_as_uint(s), __float_as_uint(s), false, false); s = __uint_as_float(r32[0]) + __uint_as_float(r32[1]); }
                if (fq == 0) atomicAdd(ss + row, s); }
    }
};
struct EpiSwiGLU {
    static constexpr bool PERM = true, AFTER_DRAIN = false;
    bf16_t* O;
    __device__ __forceinline__ void operator()(const f32x4 (&acc)[2][2][4][2], const Unit& u, int wr, int wc, int fr, int fq) const {
        const int row0 = u.pm * BM + wr * 64 + fr, col0 = u.pn * 128 + wc * 32 + 8 * fq;
#pragma unroll
        for (int ai = 0; ai < 2; ++ai)
#pragma unroll
            for (int m = 0; m < 4; ++m) { bf16_t* rowp = O + (size_t)(row0 + ai * HALF + m * 16) * DFF + col0; float o[8];
#pragma unroll
                for (int n = 0; n < 2; ++n) { const f32x4 g = acc[ai][0][m][n], up = acc[ai][1][m][n];
#pragma unroll
                    for (int j = 0; j < 4; ++j) o[4 * n + j] = siluf_(g[j]) * up[j]; }
                u32x4 w; w.x = pk2(o[0], o[1]); w.y = pk2(o[2], o[3]); w.z = pk2(o[4], o[5]); w.w = pk2(o[6], o[7]); *(u32x4*)rowp = w; }
    }
};
struct EpiLoraW {
    static constexpr bool PERM = true, AFTER_DRAIN = false;
    const float* w0; bf16_t *DFp, *DBp;
    __device__ __forceinline__ void operator()(const f32x4 (&acc)[2][2][4][2], const Unit& u, int wr, int wc, int fr, int fq) const {
        const int row0 = u.pm * BM + wr * 64 + fr, cb = 128 * u.pn + wc * 32 + 8 * fq;
#pragma unroll
        for (int bj = 0; bj < 2; ++bj) {
            const f32x4 w0a = *(const f32x4*)(w0 + 512 * bj + cb), w0b = *(const f32x4*)(w0 + 512 * bj + cb + 4); bf16_t* D = bj ? DBp : DFp;
#pragma unroll
            for (int ai = 0; ai < 2; ++ai)
#pragma unroll
                for (int m = 0; m < 4; ++m) { const f32x4 a0 = acc[ai][bj][m][0], a1 = acc[ai][bj][m][1]; float d[8];
#pragma unroll
                    for (int j = 0; j < 4; ++j) { d[j] = 0.60653066f * sigmoidf_(w0a[j] + a0[j]); d[4 + j] = 0.60653066f * sigmoidf_(w0b[j] + a1[j]); }
                    *(u32x4*)(D + (size_t)(row0 + ai * HALF + m * 16) * 512 + cb) = pack8(d); asm volatile("" ::: "memory"); }
        }
    }
};
struct EpiLoraAG {
    static constexpr bool PERM = true, AFTER_DRAIN = false;
    const float *a0, *k_k, *k_a; const float* rinv; bf16_t *RKV, *KK, *NB, *G;
    __device__ __forceinline__ void operator()(const f32x4 (&acc)[2][2][4][2], const Unit& u, int wr, int wc, int fr, int fq) const {
        const int row0 = u.pm * BM + wr * 64 + fr, cb = 128 * u.pn + wc * 32 + 8 * fq;
#pragma unroll
        for (int ai = 0; ai < 2; ++ai)
#pragma unroll
            for (int m = 0; m < 4; ++m) { const f32x4 g0 = acc[ai][1][m][0], g1 = acc[ai][1][m][1]; u32x4 w; w.x = pk2(g0[0], g0[1]); w.y = pk2(g0[2], g0[3]); w.z = pk2(g1[0], g1[1]); w.w = pk2(g1[2], g1[3]);
                __builtin_nontemporal_store(w, (u32x4*)(G + (size_t)(row0 + ai * HALF + m * 16) * 512 + cb)); }
        asm volatile("" ::: "memory");
#pragma unroll
        for (int ai = 0; ai < 2; ++ai)
#pragma unroll
            for (int m = 0; m < 4; ++m) { const int row = row0 + ai * HALF + m * 16; const size_t off = (size_t)row * 512 + cb; bf16_t* kp = RKV + (size_t)row * 1536 + 512 + cb;
                float ks[8], av[8], t[8]; unpack8(*(const u32x4*)kp, ks);
                { const f32x4 c0 = *(const f32x4*)(a0 + cb), c1 = *(const f32x4*)(a0 + cb + 4); const f32x4 x0 = acc[ai][0][m][0], x1 = acc[ai][0][m][1];
#pragma unroll
                  for (int j = 0; j < 4; ++j) { av[j] = sigmoidf_(c0[j] + x0[j]); av[4 + j] = sigmoidf_(c1[j] + x1[j]); } }
                { const f32x4 c0 = *(const f32x4*)(k_a + cb), c1 = *(const f32x4*)(k_a + cb + 4);
#pragma unroll
                  for (int j = 0; j < 4; ++j) { t[j] = ks[j] * (1.0f + (av[j] - 1.0f) * c0[j]); t[4 + j] = ks[4 + j] * (1.0f + (av[4 + j] - 1.0f) * c1[j]); } }
                *(u32x4*)kp = pack8(t);
                { const f32x4 c0 = *(const f32x4*)(k_k + cb), c1 = *(const f32x4*)(k_k + cb + 4); const float ri = rinv[row * 8 + (cb >> 6)];
#pragma unroll
                  for (int j = 0; j < 4; ++j) { t[j] = ks[j] * c0[j] * ri; t[4 + j] = ks[4 + j] * c1[j] * ri; } }
                *(u32x4*)(KK + off) = pack8(t);
#pragma unroll
                for (int e = 0; e < 8; ++e) t[e] = -t[e] * av[e];
                *(u32x4*)(NB + off) = pack8(t);
                asm volatile("" ::: "memory"); }
    }
};
struct EpiPleGate {
    static constexpr bool PERM = true, AFTER_DRAIN = false;
    bf16_t* C; const float* bias; const bf16_t* E; float* ss;
    __device__ __forceinline__ void operator()(const f32x4 (&acc)[2][2][4][2], const Unit& u, int wr, int wc, int fr, int fq) const {
        const int row0 = u.pm * BM + wr * 64 + fr, col0 = u.pn * BM + wc * 32 + 8 * fq;
        f32x4 bv[2][2];
#pragma unroll
        for (int bj = 0; bj < 2; ++bj)
#pragma unroll
            for (int n = 0; n < 2; ++n) bv[bj][n] = *(const f32x4*)(bias + col0 + bj * HALF + 4 * n);
#pragma unroll
        for (int ai = 0; ai < 2; ++ai)
#pragma unroll
            for (int m = 0; m < 4; ++m) { const int row = row0 + ai * HALF + m * 16; const size_t off = (size_t)row * DM + col0; float s = 0.f;
#pragma unroll
                for (int bj = 0; bj < 2; ++bj) { float e[8], o[8]; unpack8(*(const u32x4*)(E + off + bj * HALF), e);
#pragma unroll
                    for (int n = 0; n < 2; ++n) { const f32x4 v = acc[ai][bj][m][n] + bv[bj][n];
#pragma unroll
                        for (int j = 0; j < 4; ++j) { o[4 * n + j] = sigmoidf_(v[j]) * e[4 * n + j]; s += o[4 * n + j] * o[4 * n + j]; } }
                    __builtin_nontemporal_store(pack8(o), (u32x4*)(C + off + bj * HALF)); }
                { auto r16 = __builtin_amdgcn_permlane16_swap(__float_as_uint(s), __float_as_uint(s), false, false); s = __uint_as_float(r16[0]) + __uint_as_float(r16[1]);
                  auto r32 = __builtin_amdgcn_permlane32_swap(__float_as_uint(s), __float_as_uint(s), false, false); s = __uint_as_float(r32[0]) + __uint_as_float(r32[1]); }
                if (fq == 0) atomicAdd(ss + row, s); }
    }
};
#define XB_TMO      128
#define XB_XCNT(j)  (256  + 64 * (j))
#define XB_XSUB(j)  (1280 + 64 * (j))
#define XB_XGEN(j)  (2304 + 64 * (j))
#define XB_TOP      3328
#define XB_TOPGEN   3392
#define XCD_BAR_WORDS 3456
#define XB_SPIN_CAP (1u << 18)

__device__ __forceinline__ unsigned xb_ld(unsigned* p)              { return __hip_atomic_load(p, __ATOMIC_RELAXED, __HIP_MEMORY_SCOPE_AGENT); }
__device__ __forceinline__ unsigned xb_add(unsigned* p, unsigned v) { return __hip_atomic_fetch_add(p, v, __ATOMIC_RELAXED, __HIP_MEMORY_SCOPE_AGENT); }
__device__ __forceinline__ unsigned xb_xcc_id() { return (unsigned)__builtin_amdgcn_s_getreg((3 << 11) | 20) & 0xFu; }
#define XB_SPIN(cond, bar) do { unsigned _sp = 0; while (cond) { __builtin_amdgcn_s_sleep(1); \
    if ((++_sp & 255u) == 0u) { if (xb_ld(&(bar)[XB_TMO])) break; if (_sp > XB_SPIN_CAP) { atomicAdd(&(bar)[XB_TMO], 1u); break; } } } } while (0)

struct XcdBarrier {
    unsigned* bar; unsigned x;
    volatile LAS unsigned* st;
};

__device__ __forceinline__ XcdBarrier xcd_barrier_post(unsigned* bar, volatile LAS unsigned* st) {
    XcdBarrier b; b.bar = bar; b.x = xb_xcc_id(); b.st = st;
    if (threadIdx.x == 0) (void)xb_add(&bar[XB_XCNT(b.x)], 1u);
    return b;
}
__device__ __forceinline__ void xcd_barrier_complete(unsigned* bar, unsigned x, unsigned& nloc, unsigned& nx) {
    const unsigned G = gridDim.x * gridDim.y * gridDim.z;
    unsigned sum, cnt, mine, sp = 0u;
    for (;;) {
        sum = 0u; cnt = 0u; mine = 0u;
#pragma unroll
        for (unsigned j = 0; j < 16; ++j) { const unsigned c = xb_ld(&bar[XB_XCNT(j)]); sum += c; cnt += (c > 0u) ? 1u : 0u; mine = (j == x) ? c : mine; }
        if (sum == G) break;
        __builtin_amdgcn_s_sleep(1);
        if ((++sp & 255u) == 0u) { if (xb_ld(&bar[XB_TMO])) break; if (sp > XB_SPIN_CAP) { atomicAdd(&bar[XB_TMO], 1u); break; } }
    }
    nloc = mine > 0u ? mine : 1u; nx = cnt > 0u ? cnt : 1u;
}

__device__ __forceinline__ void xcd_barrier(const XcdBarrier& b) {
    asm volatile("s_waitcnt vmcnt(0)" ::: "memory");
    __syncthreads();
    if (threadIdx.x == 0) {
        unsigned* bar = b.bar;
        __builtin_amdgcn_s_waitcnt(0);
        unsigned nloc = b.st[0], nx = b.st[1];
        if (nloc == 0u) { xcd_barrier_complete(bar, b.x, nloc, nx); b.st[0] = nloc; b.st[1] = nx; }
        const unsigned old = xb_add(&bar[XB_XSUB(b.x)], 1u);
        const unsigned gen = old / nloc;
        if (old + 1u == (gen + 1u) * nloc) {
            __builtin_amdgcn_fence(__ATOMIC_RELEASE, "agent");
            asm volatile("s_waitcnt vmcnt(0)" ::: "memory");
            const unsigned og = xb_add(&bar[XB_TOP], 1u);
            const unsigned tg = og / nx;
            if (og + 1u == (tg + 1u) * nx) xb_add(&bar[XB_TOPGEN], 1u);
            else XB_SPIN(xb_ld(&bar[XB_TOPGEN]) == tg, bar);
            __builtin_amdgcn_fence(__ATOMIC_ACQUIRE, "agent");
            xb_add(&bar[XB_XGEN(b.x)], 1u);
            asm volatile("s_waitcnt vmcnt(0)" ::: "memory");
        } else {
            XB_SPIN(xb_ld(&bar[XB_XGEN(b.x)]) == gen, bar);
            __builtin_amdgcn_fence(__ATOMIC_ACQUIRE, "agent");
            asm volatile("s_waitcnt vmcnt(0)" ::: "memory");
        }
    }
    __syncthreads();
}

__device__ __forceinline__ float red8s(float x) {
    x += __int_as_float(__builtin_amdgcn_update_dpp(0, __float_as_int(x), 0xB1, 0xF, 0xF, true));
    x += __int_as_float(__builtin_amdgcn_update_dpp(0, __float_as_int(x), 0x4E, 0xF, 0xF, true));
    x += __int_as_float(__builtin_amdgcn_update_dpp(0, __float_as_int(x), 0x141, 0xF, 0xF, true));
    return x;
}
__device__ __forceinline__ float red16s(float x) { x = red8s(x); x += __int_as_float(__builtin_amdgcn_update_dpp(0, __float_as_int(x), 0x140, 0xF, 0xF, true)); return x; }
__device__ __forceinline__ void transpose_item(const float* W, int N, int col0, bf16_t* WT, int K, int drow0, int k0, LAS float* scr, int lane) {
#pragma unroll 8
    for (int i = 0; i < 32; ++i) { const int kk = 2 * i + (lane >> 5); scr[kk * 33 + (lane & 31)] = col0 >= 0 ? __builtin_nontemporal_load(W + (size_t)(k0 + kk) * N + col0 + (lane & 31)) : 0.f; }
    asm volatile("s_waitcnt lgkmcnt(0)" ::: "memory");
    const int c = lane & 7;
#pragma unroll
    for (int j = 0; j < 4; ++j) { const int n = (lane >> 3) + 8 * j; const LAS float* s = scr + (8 * c) * 33 + n;
        u32x4 o; o.x = pk2(s[0 * 33], s[1 * 33]); o.y = pk2(s[2 * 33], s[3 * 33]); o.z = pk2(s[4 * 33], s[5 * 33]); o.w = pk2(s[6 * 33], s[7 * 33]);
        *(u32x4*)(WT + (size_t)(drow0 + n) * K + k0 + 8 * c) = o; }
    asm volatile("s_waitcnt lgkmcnt(0)" ::: "memory");
}
__device__ __forceinline__ void phase0(const Params& p, LAS unsigned char* lds, int wid, int lane) {
    unsigned char* ws = p.ws;
    LAS float* scr = (LAS float*)(lds + wid * 8448);
    const int gw = blockIdx.x * 8 + wid, NGW = gridDim.x * 8;
    constexpr int I1 = 16 * 112, I3 = 16 * 32, I4 = 16 * 176, I5 = 44 * 32, I6 = 4 * 32, I7 = 16 * 32, NIT = I1 + I3 + I4 + I5 + I6 + I7;
    for (int it = gw; it < NIT; it += NGW) {
        int r = it;
        if (r < I1) { const int kb = r / 112, nb = r % 112; transpose_item(p.in[7], 3424, nb * 32 < 3424 ? nb * 32 : -1, (bf16_t*)(ws + WS_W1T), 1024, nb * 32, kb * 64, scr, lane); continue; } r -= I1;
        if (r < I3) { const int kb = r / 32, nb = r % 32; transpose_item(p.in[23], 1024, nb * 32, (bf16_t*)(ws + WS_W3T), 1024, nb * 32, kb * 64, scr, lane); continue; } r -= I3;
        if (r < I4) { const int kb = r / 176, nb = r % 176, n0 = nb * 32, u = n0 >> 8, bj = (n0 >> 7) & 1, cc = n0 & 127;
            transpose_item(bj ? p.in[25] : p.in[24], DFF, 128 * u + cc, (bf16_t*)(ws + WS_W4T), 1024, n0, kb * 64, scr, lane); continue; } r -= I4;
        if (r < I5) { const int kb = r / 32, nb = r % 32; transpose_item(p.in[26], 1024, nb * 32, (bf16_t*)(ws + WS_W5T), DFF, nb * 32, kb * 64, scr, lane); continue; } r -= I5;
        if (r < I6) { const int kb = r / 32, nb = r % 32; transpose_item(p.in[27], 1024, nb * 32, (bf16_t*)(ws + WS_W6T), 256, nb * 32, kb * 64, scr, lane); continue; } r -= I6;
        { const int kb = r / 32, nb = r % 32; transpose_item(p.in[28], 1024, nb * 32, (bf16_t*)(ws + WS_W7T), 1024, nb * 32, kb * 64, scr, lane); }
    }
    const int gt = blockIdx.x * 512 + threadIdx.x, GT = gridDim.x * 512;
    {
        bf16_t* W2 = (bf16_t*)(ws + WS_W2T); const float* wup = p.in[10]; const float* aup = p.in[12]; const float* gup = p.in[13];
        for (int idx = gt; idx < 2048 * KLORA; idx += GT) { const int n = idx / KLORA, kk = idx % KLORA, u = n >> 8, bj = (n >> 7) & 1, col = 128 * (u & 3) + (n & 127); float v = 0.f;
            if (u < 4) { if (bj == 0) { if (kk < 64) v = wup[(size_t)kk * 512 + col]; } else { if (kk >= 64 && kk < 128) v = wup[(size_t)(64 + kk - 64) * 512 + col]; } }
            else { if (bj == 0) { if (kk >= 128 && kk < 192) v = aup[(size_t)(kk - 128) * 512 + col]; } else { if (kk >= 192 && kk < 320) v = gup[(size_t)(kk - 192) * 512 + col]; } }
            W2[idx] = (bf16_t)(pk2(v, 0.f) & 0xffffu); }
    }
    {
        const f32x4* src = (const f32x4*)p.in[1]; u32x2* dst = (u32x2*)(ws + WS_PB);
        for (int i = gt; i < M_TOK * 256 / 4; i += GT) { const f32x4 v = __builtin_nontemporal_load(src + i); u32x2 w; w.x = pk2(v[0], v[1]); w.y = pk2(v[2], v[3]); dst[i] = w; }
        float* ss = (float*)(ws + WS_SS);
        for (int i = gt; i < 3 * M_TOK; i += GT) ss[i] = 0.f;
    }
    {
        const float* nw = p.in[2]; f32x4 wv[4];
#pragma unroll
        for (int j = 0; j < 4; ++j) wv[j] = *(const f32x4*)(nw + 4 * lane + 256 * j);
        bf16_t* XN = (bf16_t*)(ws + WS_XN);
        for (int t = gw; t < M_TOK; t += NGW) { const float* xr = p.in[0] + (size_t)t * DM; f32x4 v[4]; float s = 0.f;
#pragma unroll
            for (int j = 0; j < 4; ++j) { v[j] = __builtin_nontemporal_load((const f32x4*)(xr + 4 * lane + 256 * j)); s += (v[j][0] * v[j][0] + v[j][1] * v[j][1]) + (v[j][2] * v[j][2] + v[j][3] * v[j][3]); }
            const float rs = rsqrtf(wave_sum(s) * (1.0f / DM) + NEPS);
#pragma unroll
            for (int j = 0; j < 4; ++j) { const f32x4 o = v[j] * rs * wv[j]; u32x2 w; w.x = pk2(o[0], o[1]); w.y = pk2(o[2], o[3]); *(u32x2*)(XN + (size_t)t * DM + 4 * lane + 256 * j) = w; } }
    }
}
template <int CH> __device__ __forceinline__ void p2_rwkv_chunk(const Params& p, int t0, int lane) {
    unsigned char* ws = p.ws;
    const int chunk = lane + 64 * CH, c = chunk * 8;
    bf16_t* RKV = (bf16_t*)(ws + WS_RKV); bf16_t* AP = (bf16_t*)p.out; float* RINV = (float*)(ws + WS_RINV);
    if (CH == 3 && chunk >= 232) {
        if (chunk < 240) { const u32x4 zero = {0u, 0u, 0u, 0u};
#pragma unroll 4
            for (int i = 0; i < 16; ++i) *(u32x4*)(AP + (size_t)(t0 + i) * KLORA + 320 + (chunk - 232) * 8) = zero; }
        return; }
    const bf16_t* zc = (const bf16_t*)(ws + WS_Z) + (size_t)t0 * ZLD + c;
    float mu[8], kq[8];
    { const f32x4 m0 = *(const f32x4*)(p.in[8] + c), m1 = *(const f32x4*)(p.in[8] + c + 4);
#pragma unroll
      for (int i = 0; i < 4; ++i) { mu[i] = m0[i]; mu[4 + i] = m1[i]; } }
    if (CH == 1) { const f32x4 q0 = *(const f32x4*)(p.in[14] + c - 512), q1 = *(const f32x4*)(p.in[14] + c - 512 + 4);
#pragma unroll
        for (int i = 0; i < 4; ++i) { kq[i] = q0[i]; kq[4 + i] = q1[i]; } }
    float P[8], C[8], N[8];
    if ((t0 & (T_SEQ - 1)) != 0) unpack8(__builtin_nontemporal_load((const u32x4*)(zc - ZLD)), P); else {
#pragma unroll
        for (int i = 0; i < 8; ++i) P[i] = 0.f; }
    unpack8(__builtin_nontemporal_load((const u32x4*)(zc)), C);
    u32x4 raw = __builtin_nontemporal_load((const u32x4*)(zc + ZLD));
#pragma unroll 2
    for (int i = 0; i < 16; ++i) {
        const int t = t0 + i; const bool hasn = (t & (T_SEQ - 1)) != T_SEQ - 1;
        if (hasn) unpack8(raw, N); else {
#pragma unroll
            for (int q = 0; q < 8; ++q) N[q] = 0.f; }
        if (i < 15 && ((t + 1) & (T_SEQ - 1)) != T_SEQ - 1) raw = __builtin_nontemporal_load((const u32x4*)(zc + (size_t)(i + 2) * ZLD));
        float zs[8];
#pragma unroll
        for (int q = 0; q < 8; ++q) zs[q] = C[q] + mu[q] * (0.5f * (P[q] + N[q]) - C[q]);
        if (CH < 3) {
            *(u32x4*)(RKV + (size_t)t * 1536 + c) = pack8(zs);
            if (CH == 1) { float s2 = 0.f;
#pragma unroll
                for (int q = 0; q < 8; ++q) { const float v = zs[q] * kq[q]; s2 += v * v; }
                s2 = red8s(s2);
                if ((lane & 7) == 0) RINV[t * 8 + (lane >> 3)] = rsqrtf(fmaxf(s2, 1e-24f)); }
        } else {
            const int cc = c - 1536; float o[8];
#pragma unroll
            for (int q = 0; q < 8; ++q) o[q] = cc < 128 ? tanhf_(zs[q]) : (cc < 192 ? zs[q] : sigmoidf_(zs[q]));
            *(u32x4*)(AP + (size_t)t * KLORA + cc) = pack8(o);
        }
#pragma unroll
        for (int q = 0; q < 8; ++q) { P[q] = C[q]; C[q] = N[q]; }
    }
}
template <int CH> __device__ __forceinline__ void p2_gla_chunk(const Params& p, int t0, int lane) {
    unsigned char* ws = p.ws;
    const int c = (lane + 64 * CH) * 8; const float sc = c < 256 ? 0.125f : 1.0f;
    bf16_t* GQKV = (bf16_t*)(ws + WS_GQKV);
    const bf16_t* zc = (const bf16_t*)(ws + WS_Z) + (size_t)t0 * ZLD + NRW + c;
    float w0[8], w1[8], w2[8];
#pragma unroll
    for (int h = 0; h < 2; ++h) { const f32x4 a = *(const f32x4*)(p.in[19] + c + 4 * h), b = *(const f32x4*)(p.in[19] + 1024 + c + 4 * h), d = *(const f32x4*)(p.in[19] + 2048 + c + 4 * h);
#pragma unroll
        for (int i = 0; i < 4; ++i) { w0[4 * h + i] = a[i]; w1[4 * h + i] = b[i]; w2[4 * h + i] = d[i]; } }
    float P[8], C[8], N[8];
    if ((t0 & (T_SEQ - 1)) != 0) unpack8(__builtin_nontemporal_load((const u32x4*)(zc - ZLD)), P); else {
#pragma unroll
        for (int i = 0; i < 8; ++i) P[i] = 0.f; }
    unpack8(__builtin_nontemporal_load((const u32x4*)(zc)), C);
    u32x4 raw = __builtin_nontemporal_load((const u32x4*)(zc + ZLD));
#pragma unroll 2
    for (int i = 0; i < 16; ++i) {
        const int t = t0 + i; const bool hasn = (t & (T_SEQ - 1)) != T_SEQ - 1;
        if (hasn) unpack8(raw, N); else {
#pragma unroll
            for (int q = 0; q < 8; ++q) N[q] = 0.f; }
        if (i < 15 && ((t + 1) & (T_SEQ - 1)) != T_SEQ - 1) raw = __builtin_nontemporal_load((const u32x4*)(zc + (size_t)(i + 2) * ZLD));
        float o[8];
#pragma unroll
        for (int q = 0; q < 8; ++q) { const float y = w0[q] * P[q] + w1[q] * C[q] + w2[q] * N[q]; o[q] = siluf_(y) * sc; }
        *(u32x4*)(GQKV + (size_t)t * 1024 + c) = pack8(o);
#pragma unroll
        for (int q = 0; q < 8; ++q) { P[q] = C[q]; C[q] = N[q]; }
    }
}
__device__ __forceinline__ void p2_gate(const Params& p, const LAS float* aup, int t0, int lane) {
    unsigned char* ws = p.ws; bf16_t* GNL = (bf16_t*)(ws + WS_GNL); bf16_t* GG = (bf16_t*)(ws + WS_GG); const float* ab = p.in[21];
    const f32x4 ab0 = *(const f32x4*)(ab + 4 * lane), ab1 = *(const f32x4*)(ab + 256 + 4 * lane);
#pragma unroll 2
    for (int i = 0; i < 16; ++i) {
        const int t = t0 + i; const bf16_t* zg = (const bf16_t*)(ws + WS_Z) + (size_t)t * ZLD + NRW;
        *(u32x4*)(GG + (size_t)t * 512 + lane * 8) = __builtin_nontemporal_load((const u32x4*)(zg + 1024 + lane * 8));
        const unsigned short araw = zg[1536 + (lane & 31)]; const int alo = (int)((unsigned)araw << 16);
        f32x4 acc0 = ab0, acc1 = ab1;
#pragma unroll
        for (int r = 0; r < 16; ++r) { const float a0 = __int_as_float(__builtin_amdgcn_readlane(alo, r)), a1 = __int_as_float(__builtin_amdgcn_readlane(alo, 16 + r));
            acc0 += a0 * *(const LAS f32x4*)(aup + r * 256 + 4 * lane); acc1 += a1 * *(const LAS f32x4*)(aup + (16 + r) * 256 + 4 * lane); }
        float n0[4], n1[4];
#pragma unroll
        for (int j = 0; j < 4; ++j) { const float y0 = -acc0[j], y1 = -acc1[j];
            n0[j] = (fmaxf(y0, 0.f) + __logf(1.0f + __expf(-fabsf(y0)))) * 0.0625f; n1[j] = (fmaxf(y1, 0.f) + __logf(1.0f + __expf(-fabsf(y1)))) * 0.0625f; }
        u32x2 w; w.x = pk2(n0[0], n0[1]); w.y = pk2(n0[2], n0[3]); *(u32x2*)(GNL + (size_t)t * 512 + 4 * lane) = w;
        w.x = pk2(n1[0], n1[1]); w.y = pk2(n1[2], n1[3]); *(u32x2*)(GNL + (size_t)t * 512 + 256 + 4 * lane) = w;
    }
}
__device__ __forceinline__ void phase2(const Params& p, LAS unsigned char* lds, int wid, int lane) {
    const float* aupg = p.in[20];
    LAS float* aup = (LAS float*)lds;
    for (int i = threadIdx.x; i < 2 * 16 * 256; i += 512) aup[i] = aupg[i];
    __syncthreads();
    const int gw = blockIdx.x * 8 + wid, NGW = gridDim.x * 8;
    for (int grp = gw; grp < M_TOK / 16; grp += NGW) {
        const int t0 = grp * 16;
        p2_rwkv_chunk<0>(p, t0, lane); p2_rwkv_chunk<1>(p, t0, lane); p2_rwkv_chunk<2>(p, t0, lane); p2_rwkv_chunk<3>(p, t0, lane);
        p2_gla_chunk<0>(p, t0, lane); p2_gla_chunk<1>(p, t0, lane);
        p2_gate(p, aup, t0, lane);
    }
}
constexpr int SC_CH = 16;
constexpr int SB_XA = 0, SB_XB = 4608, SB_XBT = 9216, SB_VT = 14336, SB_WE = 17408, SC_BUF = 17664;
constexpr int SW_GR = 0, SW_HT = 1024, SW_GYT = 2560, SW_TIT = 4096, SW_SIZE = 5632, SC_IMG = 4 * SC_BUF;
typedef float f32x16 __attribute__((ext_vector_type(16)));
typedef __bf16 bf16x2_t __attribute__((ext_vector_type(2)));
__device__ __forceinline__ unsigned cvt2(float a, float b) { f32x2 v = {a, b}; bf16x2_t r = __builtin_convertvector(v, bf16x2_t); return __builtin_bit_cast(unsigned, r); }
__device__ __forceinline__ bf16x8 pack8r(float a, float b, float c, float d, float e, float f, float g, float hh) { u32x4 p; p.x = cvt2(a, b); p.y = cvt2(c, d); p.z = cvt2(e, f); p.w = cvt2(g, hh); return __builtin_bit_cast(bf16x8, p); }
#define MFMA32(a, b, c) __builtin_amdgcn_mfma_f32_32x32x16_bf16((a), (b), (c), 0, 0, 0)
struct ScanSrc { const bf16_t* v[6]; int ld[6]; bf16_t* out; int rev; int tokbase; };
struct ScanLd { u32x2 rd, rk, rr, rv, rkk, rnb; };
template <bool RWKV> __device__ __forceinline__ void scan_load_issue(ScanLd& L, const ScanSrc& S, int chunk, int lt) {
    const int lw = lt >> 6, lane = lt & 63, sl = lane >> 2, col = 16 * lw + 4 * (lane & 3), s = chunk * SC_CH + sl; const size_t tok = (size_t)(S.tokbase + (S.rev ? T_SEQ - 1 - s : s));
    L.rd = *(const u32x2*)(S.v[0] + tok * S.ld[0] + col); L.rk = *(const u32x2*)(S.v[1] + tok * S.ld[1] + col); L.rr = *(const u32x2*)(S.v[4] + tok * S.ld[4] + col); L.rv = *(const u32x2*)(S.v[5] + tok * S.ld[5] + col);
    L.rkk = L.rk; L.rnb = L.rk;
    if (RWKV) { L.rkk = *(const u32x2*)(S.v[2] + tok * S.ld[2] + col); L.rnb = *(const u32x2*)(S.v[3] + tok * S.ld[3] + col); }
}
template <bool RWKV> __device__ __forceinline__ void scan_load_finish(LAS unsigned char* buf, const ScanLd& L, int lt) {
    const int lw = lt >> 6, lane = lt & 63, sl = lane >> 2, col = 16 * lw + 4 * (lane & 3);
    float d[4], c[4], k[4], r[4], v[4], kk[4], nb[4];
    unpack4(L.rd, d); unpack4(L.rk, k); unpack4(L.rr, r); unpack4(L.rv, v); unpack4(L.rkk, kk); unpack4(L.rnb, nb);
#pragma unroll
    for (int i = 0; i < 4; ++i) c[i] = d[i];
#pragma unroll
    for (int dl = 4; dl < 64; dl <<= 1)
#pragma unroll
        for (int i = 0; i < 4; ++i) { const float t = __shfl_up(c[i], dl); c[i] += (lane >= dl) ? t : 0.f; }
    float o1[4], o2[4], o3[4], o4[4]; f32x4 we;
#pragma unroll
    for (int i = 0; i < 4; ++i) { const float W = __expf(-c[i]), iW = __expf(c[i]), Wp = __expf(d[i] - c[i]); o1[i] = RWKV ? kk[i] * Wp : 0.f; o2[i] = RWKV ? nb[i] * iW : 0.f; o3[i] = k[i] * iW; o4[i] = r[i] * W; we[i] = W; }
    u32x2 w;
    w.x = cvt2(o1[0], o1[1]); w.y = cvt2(o1[2], o1[3]); *(LAS u32x2*)(buf + SB_XA + sl * 144 + col * 2) = w;
    w.x = cvt2(o4[0], o4[1]); w.y = cvt2(o4[2], o4[3]); *(LAS u32x2*)(buf + SB_XA + (16 + sl) * 144 + col * 2) = w;
    w.x = cvt2(o2[0], o2[1]); w.y = cvt2(o2[2], o2[3]); *(LAS u32x2*)(buf + SB_XB + sl * 144 + col * 2) = w;
    w.x = cvt2(o3[0], o3[1]); w.y = cvt2(o3[2], o3[3]); *(LAS u32x2*)(buf + SB_XB + (16 + sl) * 144 + col * 2) = w;
#pragma unroll
    for (int i = 0; i < 4; ++i) {
        *(LAS unsigned short*)(buf + SB_XBT + (col + i) * 80 + sl * 2) = (unsigned short)(cvt2(o2[i], 0.f) & 0xffffu);
        *(LAS unsigned short*)(buf + SB_XBT + (col + i) * 80 + (16 + sl) * 2) = (unsigned short)(cvt2(o3[i], 0.f) & 0xffffu);
        *(LAS unsigned short*)(buf + SB_VT + (col + i) * 48 + sl * 2) = (unsigned short)(cvt2(v[i], 0.f) & 0xffffu); }
    if (sl == SC_CH - 1) *(LAS f32x4*)(buf + SB_WE + col * 4) = we;
}
template <bool RWKV> __device__ __forceinline__ void scan_prep_m1(const LAS unsigned char* buf, LAS unsigned char* img, int lane) {
    const int r = lane & 31, h = lane >> 5;
    f32x16 gh;
#pragma unroll
    for (int i = 0; i < 16; ++i) gh[i] = 0.f;
#pragma unroll
    for (int kb = 0; kb < 4; ++kb) { const bf16x8 a = *(const LAS bf16x8*)(buf + SB_XB + r * 144 + (16 * kb + 8 * h) * 2), b = *(const LAS bf16x8*)(buf + SB_XA + r * 144 + (16 * kb + 8 * h) * 2); gh = MFMA32(a, b, gh); }
    const int lim = r < 16 ? r : r - 15;
#pragma unroll
    for (int g = 0; g < 2; ++g) { const int t0 = 8 * g + 4 * h; float x[4], y[4];
#pragma unroll
        for (int q = 0; q < 4; ++q) { x[q] = (t0 + q < lim) ? gh[4 * g + q] : 0.f; y[q] = (t0 + q < lim) ? gh[8 + 4 * g + q] : 0.f; }
        if (RWKV && r < 16) {
#pragma unroll
            for (int q = 0; q < 4; ++q) *(LAS float*)(img + SW_GR + ((t0 + q) * 16 + r) * 4) = x[q]; }
        u32x2 wv; wv.x = r >= 16 ? cvt2(x[0], x[1]) : 0u; wv.y = r >= 16 ? cvt2(x[2], x[3]) : 0u; *(LAS u32x2*)(img + SW_GYT + r * 48 + t0 * 2) = wv;
        wv.x = cvt2(y[0], y[1]); wv.y = cvt2(y[2], y[3]); *(LAS u32x2*)(img + SW_HT + r * 48 + t0 * 2) = wv; }
}
template <bool RWKV> __device__ __forceinline__ void scan_prep_inv(LAS unsigned char* img, int lane) {
    const int r = lane & 31;
    if (RWKV) {
        const int sc = lane & 15; float X[16];
#pragma unroll
        for (int t = 15; t >= 0; --t) { float acc = (t == sc) ? 1.f : 0.f;
#pragma unroll
            for (int m4 = (t + 1) / 4; m4 < 4; ++m4) { const f32x4 gv = *(const LAS f32x4*)(img + SW_GR + (t * 16 + 4 * m4) * 4);
#pragma unroll
                for (int q = 0; q < 4; ++q) if (4 * m4 + q > t) acc = fmaf(gv[q], X[4 * m4 + q], acc); }
            X[t] = acc; }
        if (lane < 32) { u32x4 p0, p1; const bool z = r >= 16;
            p0.x = z ? 0u : cvt2(X[0], X[1]); p0.y = z ? 0u : cvt2(X[2], X[3]); p0.z = z ? 0u : cvt2(X[4], X[5]); p0.w = z ? 0u : cvt2(X[6], X[7]);
            p1.x = z ? 0u : cvt2(X[8], X[9]); p1.y = z ? 0u : cvt2(X[10], X[11]); p1.z = z ? 0u : cvt2(X[12], X[13]); p1.w = z ? 0u : cvt2(X[14], X[15]);
            *(LAS u32x4*)(img + SW_TIT + r * 48) = p0; *(LAS u32x4*)(img + SW_TIT + r * 48 + 16) = p1; }
    }
}
__device__ __forceinline__ bf16x8 lds_aperm(const LAS unsigned char* rowp, int h) {
    const u32x2 a0 = *(const LAS u32x2*)(rowp + 8 * h), a1 = *(const LAS u32x2*)(rowp + 16 + 8 * h); u32x4 aa; aa.x = a0.x; aa.y = a0.y; aa.z = a1.x; aa.w = a1.y; return __builtin_bit_cast(bf16x8, aa);
}
template <bool RWKV> __device__ __forceinline__ void scan_chunk(const LAS unsigned char* buf, const LAS unsigned char* img, f32x16 (&T)[2], const ScanSrc& S, int chunk, int w, int lane) {
    const int r = lane & 31, h = lane >> 5;
    f32x16 zero;
#pragma unroll
    for (int i = 0; i < 16; ++i) zero[i] = 0.f;
    const bf16x8 vb = *(const LAS bf16x8*)(buf + SB_VT + (32 * w + r) * 48 + 16 * h);
    f32x16 ry = zero, ry2 = zero;
#pragma unroll
    for (int kb = 0; kb < 2; ++kb) {
        const bf16x8 b0 = pack8r(T[0][8 * kb], T[0][8 * kb + 1], T[0][8 * kb + 2], T[0][8 * kb + 3], T[0][8 * kb + 4], T[0][8 * kb + 5], T[0][8 * kb + 6], T[0][8 * kb + 7]);
        const bf16x8 b1 = pack8r(T[1][8 * kb], T[1][8 * kb + 1], T[1][8 * kb + 2], T[1][8 * kb + 3], T[1][8 * kb + 4], T[1][8 * kb + 5], T[1][8 * kb + 6], T[1][8 * kb + 7]);
        ry = MFMA32(lds_aperm(buf + SB_XA + r * 144 + (16 * kb) * 2, h), b0, ry);
        ry2 = MFMA32(lds_aperm(buf + SB_XA + r * 144 + (32 + 16 * kb) * 2, h), b1, ry2); }
    { const bf16x8 a = *(const LAS bf16x8*)(img + SW_HT + r * 48 + 16 * h); ry = MFMA32(a, vb, ry); }
#pragma unroll
    for (int i = 0; i < 16; ++i) ry[i] += ry2[i];
    bf16x8 ub;
    if (RWKV) {
        const bf16x8 rb = pack8r(ry[0], ry[1], ry[2], ry[3], ry[4], ry[5], ry[6], ry[7]);
        const f32x16 ua = MFMA32(lds_aperm(img + SW_TIT + r * 48, h), rb, zero);
        ub = pack8r(ua[0], ua[1], ua[2], ua[3], ua[4], ua[5], ua[6], ua[7]);
        ry = MFMA32(lds_aperm(img + SW_GYT + r * 48, h), ub, ry);
    }
    {
        const int s0 = chunk * SC_CH; const long tok0 = (long)S.tokbase + (S.rev ? T_SEQ - 1 - s0 : s0), dstep = S.rev ? -512 : 512;
        bf16_t* op = S.out + tok0 * 512 + 32 * w + r;
#pragma unroll
        for (int q = 8; q < 16; ++q) { const int s = (q & 3) + 8 * ((q >> 2) - 2) + 4 * h; op[s * dstep] = (bf16_t)(cvt2(ry[q], 0.f) & 0xffffu); }
    }
#pragma unroll
    for (int jt = 0; jt < 2; ++jt) {
        if (RWKV) T[jt] = MFMA32(lds_aperm(buf + SB_XBT + (32 * jt + r) * 80, h), ub, T[jt]);
        { const bf16x8 a = *(const LAS bf16x8*)(buf + SB_XBT + (32 * jt + r) * 80 + 32 + 16 * h); T[jt] = MFMA32(a, vb, T[jt]); }
#pragma unroll
        for (int g = 0; g < 4; ++g) { const f32x4 we = *(const LAS f32x4*)(buf + SB_WE + (32 * jt + 8 * g + 4 * h) * 4);
#pragma unroll
            for (int q = 0; q < 4; ++q) T[jt][4 * g + q] *= we[q]; }
    }
}
template <bool RWKV> __device__ __forceinline__ void scan_item(LAS unsigned char* lds, const ScanSrc& S, int wid, int lane) {
    f32x16 T[2];
#pragma unroll
    for (int a = 0; a < 2; ++a)
#pragma unroll
        for (int i = 0; i < 16; ++i) T[a][i] = 0.f;
    const bool is_ld = (wid == 4) | (wid == 5) | (wid == 3) | (wid == 7); const bool is_prep = wid == 2;
    const int lt = (wid == 4 ? 0 : wid == 5 ? 64 : wid == 3 ? 128 : 192) + lane;
    ScanLd L;
    constexpr int NCH = T_SEQ / SC_CH;
#define SC_BAR() do { asm volatile("s_waitcnt lgkmcnt(0)" ::: "memory"); __builtin_amdgcn_s_barrier(); asm volatile("" ::: "memory"); } while (0)
    const bool is_inv = wid == 6;
    if (is_ld) { scan_load_issue<RWKV>(L, S, 0, lt); scan_load_finish<RWKV>(lds, L, lt); scan_load_issue<RWKV>(L, S, 1, lt); scan_load_finish<RWKV>(lds + SC_BUF, L, lt);
                 scan_load_issue<RWKV>(L, S, 2, lt); scan_load_finish<RWKV>(lds + 2 * SC_BUF, L, lt); scan_load_issue<RWKV>(L, S, 3, lt); }
    __syncthreads();
    if (is_prep) { scan_prep_m1<RWKV>(lds, lds + SC_IMG, lane); scan_prep_m1<RWKV>(lds + SC_BUF, lds + SC_IMG + SW_SIZE, lane); }
    SC_BAR();
    if (is_inv) scan_prep_inv<RWKV>(lds + SC_IMG, lane);
    SC_BAR();
    int b0 = 0, i0 = 0;
    for (int c = 0; c < NCH; ++c) {
        const int i1 = i0 == 2 ? 0 : i0 + 1, i2 = i1 == 2 ? 0 : i1 + 1;
        if (is_ld) {
            if (c + 3 < NCH) scan_load_finish<RWKV>(lds + ((b0 + 3) & 3) * SC_BUF, L, lt);
            if (c + 4 < NCH) scan_load_issue<RWKV>(L, S, c + 4, lt); }
        else if (is_prep) { if (c + 2 < NCH) scan_prep_m1<RWKV>(lds + ((b0 + 2) & 3) * SC_BUF, lds + SC_IMG + i2 * SW_SIZE, lane); }
        else if (is_inv) { if (c + 1 < NCH) scan_prep_inv<RWKV>(lds + SC_IMG + i1 * SW_SIZE, lane); }
        else if (wid < 2) scan_chunk<RWKV>(lds + b0 * SC_BUF, lds + SC_IMG + i0 * SW_SIZE, T, S, c, wid, lane);
        SC_BAR();
        b0 = (b0 + 1) & 3; i0 = i1;
    }
#undef SC_BAR
}
__device__ __forceinline__ void phase3(const Params& p, LAS unsigned char* lds, int wid, int lane) {
    unsigned char* ws = p.ws; bf16_t* yo = (bf16_t*)p.out;
    const bf16_t* RKV = (const bf16_t*)(ws + WS_RKV); const bf16_t* KK = (const bf16_t*)(ws + WS_KK); const bf16_t* NB = (const bf16_t*)(ws + WS_NB);
    const bf16_t* DFp = (const bf16_t*)(ws + WS_DF); const bf16_t* DBp = (const bf16_t*)(ws + WS_DB);
    const bf16_t* GQKV = (const bf16_t*)(ws + WS_GQKV); const bf16_t* GNL = (const bf16_t*)(ws + WS_GNL);
    for (int item = blockIdx.x; item < 256; item += gridDim.x) {
        ScanSrc S;
        if (item < 128) {
            const int dir = item & 1, h = (item >> 1) & 7, b = item >> 4;
            S.v[0] = (dir ? DBp : DFp) + h * 64; S.ld[0] = 512; S.v[1] = RKV + 512 + h * 64; S.ld[1] = 1536; S.v[2] = KK + h * 64; S.ld[2] = 512; S.v[3] = NB + h * 64; S.ld[3] = 512;
            S.v[4] = RKV + h * 64; S.ld[4] = 1536; S.v[5] = RKV + 1024 + h * 64; S.ld[5] = 1536;
            S.out = yo + (size_t)dir * M_TOK * 512 + h * 64; S.rev = dir; S.tokbase = b * T_SEQ;
            scan_item<true>(lds, S, wid, lane);
        } else {
            const int i2 = item - 128, half = i2 & 1, dir = (i2 >> 1) & 1, h = (i2 >> 2) & 3, b = i2 >> 4;
            S.v[0] = GNL + dir * 256 + h * 64; S.ld[0] = 512; S.v[1] = GQKV + 256 + h * 64; S.ld[1] = 1024; S.v[2] = S.v[1]; S.ld[2] = 0; S.v[3] = S.v[1]; S.ld[3] = 0;
            S.v[4] = GQKV + h * 64; S.ld[4] = 1024; S.v[5] = GQKV + 512 + h * 128 + half * 64; S.ld[5] = 1024;
            S.out = yo + (size_t)(2 + dir) * M_TOK * 512 + h * 128 + half * 64; S.rev = dir; S.tokbase = b * T_SEQ;
            scan_item<false>(lds, S, wid, lane);
        }
        __syncthreads();
    }
}
__device__ __forceinline__ void phase4(const Params& p, int wid, int lane) {
    unsigned char* ws = p.ws; const bf16_t* yo = (const bf16_t*)p.out;
    const bf16_t* RKV = (const bf16_t*)(ws + WS_RKV); const bf16_t* G = (const bf16_t*)(ws + WS_G); const bf16_t* GG = (const bf16_t*)(ws + WS_GG); bf16_t* YM = (bf16_t*)(ws + WS_YMIX);
    const int c = lane * 8;
    float rk[8], lw[8], lb[8], gn[8];
#pragma unroll
    for (int i = 0; i < 8; ++i) { rk[i] = p.in[16][c + i]; lw[i] = p.in[17][c + i]; lb[i] = p.in[18][c + i]; gn[i] = p.in[22][(c + i) & 127]; }
    const int gw = blockIdx.x * 8 + wid, NGW = gridDim.x * 8;
    for (int t = gw; t < M_TOK; t += NGW) {
        const size_t o5 = (size_t)t * 512 + c;
        {
            float yf[8], yb[8], y[8], r[8], k[8], v[8], g[8];
            unpack8(__builtin_nontemporal_load((const u32x4*)(yo + o5)), yf); unpack8(__builtin_nontemporal_load((const u32x4*)(yo + (size_t)M_TOK * 512 + o5)), yb);
            unpack8(__builtin_nontemporal_load((const u32x4*)(RKV + (size_t)t * 1536 + c)), r); unpack8(__builtin_nontemporal_load((const u32x4*)(RKV + (size_t)t * 1536 + 512 + c)), k); unpack8(__builtin_nontemporal_load((const u32x4*)(RKV + (size_t)t * 1536 + 1024 + c)), v);
            unpack8(__builtin_nontemporal_load((const u32x4*)(G + o5)), g);
            float s = 0.f, bsum = 0.f;
#pragma unroll
            for (int i = 0; i < 8; ++i) { y[i] = yf[i] + yb[i]; s += y[i]; bsum += r[i] * k[i] * rk[i]; }
            s = red8s(s); bsum = red8s(bsum);
            const float mean = s * (1.0f / 64.0f); float q = 0.f;
#pragma unroll
            for (int i = 0; i < 8; ++i) { y[i] -= mean; q += y[i] * y[i]; }
            q = red8s(q);
            const float rstd = rsqrtf(q * (1.0f / 64.0f) + 64e-5f); float o[8];
#pragma unroll
            for (int i = 0; i < 8; ++i) o[i] = (y[i] * rstd * lw[i] + lb[i] + bsum * v[i]) * g[i];
            *(u32x4*)(YM + (size_t)t * DM + c) = pack8(o);
        }
        {
            float of[8], ob[8], o[8], g[8];
            unpack8(__builtin_nontemporal_load((const u32x4*)(yo + (size_t)2 * M_TOK * 512 + o5)), of); unpack8(__builtin_nontemporal_load((const u32x4*)(yo + (size_t)3 * M_TOK * 512 + o5)), ob); unpack8(__builtin_nontemporal_load((const u32x4*)(GG + o5)), g);
            float q = 0.f;
#pragma unroll
            for (int i = 0; i < 8; ++i) { o[i] = of[i] + ob[i]; q += o[i] * o[i]; }
            q = red16s(q);
            const float rs = rsqrtf(q * (1.0f / 128.0f) + NEPS); float r[8];
#pragma unroll
            for (int i = 0; i < 8; ++i) r[i] = o[i] * rs * gn[i] * siluf_(g[i]);
            *(u32x4*)(YM + (size_t)t * DM + 512 + c) = pack8(r);
        }
    }
}
template <int MODE> __device__ __forceinline__ void phase_row(const void* basev, const bf16_t* add, const float* ss, const float* wpost, const float* wpre, void* outv, bf16_t* HB, int wid, int lane) {
    float wp[2][8], wq[2][8];
#pragma unroll
    for (int j = 0; j < 2; ++j)
#pragma unroll
        for (int i = 0; i < 8; ++i) { wp[j][i] = wpost[8 * lane + 512 * j + i]; wq[j][i] = MODE == 0 ? wpre[8 * lane + 512 * j + i] : 1.f; }
    const int gw = blockIdx.x * 8 + wid, NGW = gridDim.x * 8;
    for (int t = gw; t < M_TOK; t += NGW) {
        const size_t off = (size_t)t * DM + 8 * lane; const float rs = rsqrtf(ss[t] * (1.0f / DM) + NEPS); float h[2][8]; float s = 0.f;
#pragma unroll
        for (int j = 0; j < 2; ++j) { float b[8], a[8];
            if (MODE == 0) { const f32x4 b0 = __builtin_nontemporal_load((const f32x4*)((const float*)basev + off + 512 * j)), b1 = __builtin_nontemporal_load((const f32x4*)((const float*)basev + off + 512 * j + 4));
#pragma unroll
                for (int i = 0; i < 4; ++i) { b[i] = b0[i]; b[4 + i] = b1[i]; } }
            else unpack8(__builtin_nontemporal_load((const u32x4*)((const bf16_t*)basev + off + 512 * j)), b);
            unpack8(__builtin_nontemporal_load((const u32x4*)(add + off + 512 * j)), a);
#pragma unroll
            for (int i = 0; i < 8; ++i) { h[j][i] = b[i] + a[i] * rs * wp[j][i]; s += h[j][i] * h[j][i]; } }
        if (MODE == 2) {
#pragma unroll
            for (int j = 0; j < 2; ++j) { float* o = (float*)outv + off + 512 * j; __builtin_nontemporal_store((f32x4){h[j][0], h[j][1], h[j][2], h[j][3]}, (f32x4*)o); __builtin_nontemporal_store((f32x4){h[j][4], h[j][5], h[j][6], h[j][7]}, (f32x4*)(o + 4)); }
        } else {
#pragma unroll
            for (int j = 0; j < 2; ++j) *(u32x4*)((bf16_t*)outv + off + 512 * j) = pack8(h[j]);
        }
        if (MODE == 0) { const float r2 = rsqrtf(wave_sum(s) * (1.0f / DM) + NEPS);
#pragma unroll
            for (int j = 0; j < 2; ++j) { float o[8];
#pragma unroll
                for (int i = 0; i < 8; ++i) o[i] = h[j][i] * r2 * wq[j][i];
                *(u32x4*)(HB + off + 512 * j) = pack8(o); } }
    }
}
__global__ void __launch_bounds__(512, 2) hymba_fwd(Params p) {
    extern __shared__ __attribute__((aligned(16))) unsigned char lds_raw[];
    LAS unsigned char* lds = (LAS unsigned char*)lds_raw;
    cg::grid_group grid = cg::this_grid();
    volatile LAS unsigned* stw = (volatile LAS unsigned*)(lds + 131072);
    if (threadIdx.x == 0) { stw[0] = 0u; stw[1] = 0u; }
    __syncthreads();
    const XcdBarrier xbar = xcd_barrier_post((unsigned*)(p.ws + WS_BAR), stw);
    int wid, lane;
#define GETWL() do { int t_ = threadIdx.x; asm volatile("" : "+v"(t_)); wid = __builtin_amdgcn_readfirstlane(t_ >> 6); lane = t_ & 63; } while (0)
    unsigned char* ws = p.ws; const int G = gridDim.x, c = blockIdx.x;
    float* SS = (float*)(ws + WS_SS);
    GETWL();
    phase0(p, lds, wid, lane);
    if (p.ws == nullptr) grid.sync();
    xcd_barrier(xbar);
    {
        Gemm g{(const bf16_t*)(ws + WS_XN), (const bf16_t*)(ws + WS_W1T), M_TOK, ZLD, DM}; StaticOrder S; S.init(M_TOK, ZLD, G, c);
        EpiBf16Plain E{(bf16_t*)(ws + WS_Z), ZLD}; gemm_phase<EpiBf16Plain, StaticOrder>(lds, g, S, E); }
    xcd_barrier(xbar);
    GETWL();
    phase2(p, lds, wid, lane);
    xcd_barrier(xbar);
    {
        Gemm g{(const bf16_t*)p.out, (const bf16_t*)(ws + WS_W2T), M_TOK, 1024, KLORA}; StaticOrder S; S.init(M_TOK, 1024, G, c);
        EpiLoraW E{p.in[9], (bf16_t*)(ws + WS_DF), (bf16_t*)(ws + WS_DB)}; gemm_phase<EpiLoraW, StaticOrder>(lds, g, S, E);
        Gemm g2{(const bf16_t*)p.out, (const bf16_t*)(ws + WS_W2T) + (size_t)1024 * KLORA, M_TOK, 1024, KLORA};
        EpiLoraAG E2{p.in[11], p.in[14], p.in[15], (const float*)(ws + WS_RINV), (bf16_t*)(ws + WS_RKV), (bf16_t*)(ws + WS_KK), (bf16_t*)(ws + WS_NB), (bf16_t*)(ws + WS_G)};
        gemm_phase<EpiLoraAG, StaticOrder>(lds, g2, S, E2); }
    xcd_barrier(xbar);
    GETWL();
    phase3(p, lds, wid, lane);
    xcd_barrier(xbar);
    GETWL();
    phase4(p, wid, lane);
    xcd_barrier(xbar);
    {
        Gemm g{(const bf16_t*)(ws + WS_YMIX), (const bf16_t*)(ws + WS_W3T), M_TOK, DM, DM}; StaticOrder S; S.init(M_TOK, DM, G, c);
        EpiBf16SS E{(bf16_t*)(ws + WS_Y), DM, SS}; gemm_phase<EpiBf16SS, StaticOrder>(lds, g, S, E); }
    xcd_barrier(xbar);
    GETWL();
    phase_row<0>(p.in[0], (const bf16_t*)(ws + WS_Y), SS, p.in[3], p.in[4], ws + WS_H1, (bf16_t*)(ws + WS_HN), wid, lane);
    xcd_barrier(xbar);
    {
        Gemm g{(const bf16_t*)(ws + WS_HN), (const bf16_t*)(ws + WS_W4T), M_TOK, 2 * DFF, DM}; StaticOrder S; S.init(M_TOK, 2 * DFF, G, c);
        EpiSwiGLU E{(bf16_t*)(ws + WS_ACT)}; gemm_phase<EpiSwiGLU, StaticOrder>(lds, g, S, E); }
    xcd_barrier(xbar);
    {
        Gemm g{(const bf16_t*)(ws + WS_ACT), (const bf16_t*)(ws + WS_W5T), M_TOK, DM, DFF}; StaticOrder S; S.init(M_TOK, DM, G, c);
        EpiBf16SS E{(bf16_t*)p.out, DM, SS + M_TOK}; gemm_phase<EpiBf16SS, StaticOrder>(lds, g, S, E);
        Gemm g2{(const bf16_t*)(ws + WS_PB), (const bf16_t*)(ws + WS_W6T), M_TOK, DM, 256}; StaticOrder S2; S2.init(M_TOK, DM, G, c);
        EpiBf16Plain E2{(bf16_t*)(ws + WS_E), DM}; gemm_phase<EpiBf16Plain, StaticOrder>(lds, g2, S2, E2); }
    xcd_barrier(xbar);
    GETWL();
    phase_row<1>(ws + WS_H1, (const bf16_t*)p.out, SS + M_TOK, p.in[5], nullptr, ws + WS_HN, nullptr, wid, lane);
    xcd_barrier(xbar);
    {
        Gemm g{(const bf16_t*)(ws + WS_HN), (const bf16_t*)(ws + WS_W7T), M_TOK, DM, DM}; StaticOrder S; S.init(M_TOK, DM, G, c);
        EpiPleGate E{(bf16_t*)(ws + WS_Y), p.in[29], (const bf16_t*)(ws + WS_E), SS + 2 * M_TOK}; gemm_phase<EpiPleGate, StaticOrder>(lds, g, S, E); }
    xcd_barrier(xbar);
    GETWL();
    phase_row<2>(ws + WS_HN, (const bf16_t*)(ws + WS_Y), SS + 2 * M_TOK, p.in[6], nullptr, p.out, nullptr, wid, lane);
}
extern "C" void kernel_launch(void* const* d_in, const int* in_sizes, int n_in, void* d_out, int out_size, void* d_ws, size_t ws_size, hipStream_t stream) {
    constexpr size_t kLds = 131072 + 64;
    static int grid_blocks = 0;
    if (!grid_blocks) {
        int dev = 0, cus = 0, per_cu = 0;
        if (n_in != 30 || out_size != M_TOK * DM || ws_size < WS_END) { fprintf(stderr, "kernel_launch: unexpected shapes (n_in %d, out %d, ws %zu, need %zu)\n", n_in, out_size, ws_size, (size_t)WS_END); grid_blocks = -1; return; }
        (void)hipGetDevice(&dev);
        (void)hipDeviceGetAttribute(&cus, hipDeviceAttributeMultiprocessorCount, dev);
        (void)hipFuncSetAttribute((const void*)hymba_fwd, hipFuncAttributeMaxDynamicSharedMemorySize, (int)kLds);
        (void)hipOccupancyMaxActiveBlocksPerMultiprocessor(&per_cu, (const void*)hymba_fwd, 512, kLds);
        if (per_cu < 1) { fprintf(stderr, "kernel_launch: occupancy query reports %d blocks/CU\n", per_cu); grid_blocks = -1; return; }
        grid_blocks = cus;
    }
    if (grid_blocks < 0) return;
    (void)hipMemsetAsync((unsigned char*)d_ws + WS_BAR, 0, XCD_BAR_WORDS * 4, stream);
    Params p{};
    for (int i = 0; i < 30; ++i) p.in[i] = (const float*)d_in[i];
    p.out = (float*)d_out; p.ws = (unsigned char*)d_ws;
    void* args[] = {&p};
    hipError_t e = hipLaunchCooperativeKernel((const void*)hymba_fwd, dim3(grid_blocks), dim3(512), args, kLds, stream);
    if (e != hipSuccess) fprintf(stderr, "cooperative launch failed: %s (grid %d)\n", hipGetErrorString(e), grid_blocks);
}
```
